# Optimizing an MI355X kernel written in HIP

```python
import math
import jax, jax.numpy as jnp
from jax import lax
import numpy as np

D_MODEL = 2048
BATCH = 4
SEQ = 2048
DEPTH = 1

HEAD_DIM = 128
SB_HEADS = 8
DIL_GROUPS = ((128, 1), (512, 4), (2048, 16))
DIL_HEADS_PER_GROUP = 4
N_DIL_GROUPS = len(DIL_GROUPS)
DIL_HEADS = DIL_HEADS_PER_GROUP * N_DIL_GROUPS
BLOCK = 128
SB_W = SB_HEADS * HEAD_DIM
DIL_W = DIL_HEADS * HEAD_DIM
DIL_OUT = DIL_HEADS_PER_GROUP * HEAD_DIM
N_BRANCHES = 2
IN_COLS = 3 * SB_W + 3 * DIL_W + N_BRANCHES * D_MODEL
D_FF = -(-8 * D_MODEL // (3 * 256)) * 256
N_MOD = 6
EPS = 1e-6

kernel_name = "hybrid_stickbreak_dilated_alibi_swiglu_adaln"


def rmsnorm(x, g):
    xf = x.astype(jnp.float32)
    y = xf * lax.rsqrt(jnp.mean(xf * xf, axis=-1, keepdims=True) + EPS)
    return (y * g.astype(jnp.float32)).astype(x.dtype)


def alibi_slopes():
    return 2.0 ** (-8.0 * (jnp.arange(DIL_HEADS, dtype=jnp.float32) + 1.0) / DIL_HEADS)


def stick_breaking_attention(q, k, v):
    B, S, H, Dh = q.shape
    nb = S // BLOCK
    scale = Dh ** -0.5
    qb = q.reshape(B, nb, BLOCK, H, Dh).transpose(1, 0, 2, 3, 4)
    key_pos = jnp.arange(S)

    def one_block(args):
        qi, blk = args
        z = jnp.einsum('bqhd,bkhd->bhqk', qi, k, preferred_element_type=jnp.float32) * scale
        q_pos = blk * BLOCK + jnp.arange(BLOCK)
        mask = key_pos[None, :] < q_pos[:, None]
        log_1m = jnp.where(mask, -jax.nn.softplus(z), 0.0)
        suffix = lax.cumsum(log_1m, axis=3, reverse=True) - log_1m
        a = jnp.where(mask, jnp.exp(jax.nn.log_sigmoid(z) + suffix), 0.0)
        return jnp.einsum('bhqk,bkhd->bqhd', a.astype(v.dtype), v)

    out = lax.map(one_block, (qb, jnp.arange(nb)))
    return out.transpose(1, 0, 2, 3, 4).reshape(B, S, H, Dh)


def dilated_window_attention(q, k, v, slopes, window, dilation):
    B, S, H, Dh = q.shape
    span = window // dilation
    L = S // dilation
    Lp = -(-L // BLOCK) * BLOCK
    nb = Lp // BLOCK
    scale = Dh ** -0.5

    def to_sub(t):
        t = t.reshape(B, L, dilation, H, Dh).transpose(0, 2, 1, 3, 4)
        t = jnp.pad(t, ((0, 0), (0, 0), (0, Lp - L), (0, 0), (0, 0)))
        return t.reshape(B, dilation, nb, BLOCK, H, Dh)

    def with_prev(t):
        prev = jnp.pad(t, ((0, 0), (0, 0), (1, 0), (0, 0), (0, 0), (0, 0)))[:, :, :-1]
        return jnp.concatenate([prev, t], axis=3)

    qs = to_sub(q)
    kk = with_prev(to_sub(k))
    vv = with_prev(to_sub(v))
    s = jnp.einsum('brnqhd,brnkhd->brnhqk', qs, kk, preferred_element_type=jnp.float32) * scale
    a_idx = jnp.arange(BLOCK)
    b_idx = jnp.arange(2 * BLOCK)
    rel = a_idx[:, None] + BLOCK - b_idx[None, :]
    blk = jnp.arange(nb)
    valid = ((rel >= 0) & (rel <= span))[None] & ((blk[:, None, None] > 0) | (b_idx[None, None, :] >= BLOCK))
    bias = -slopes[:, None, None] * (dilation * rel).astype(jnp.float32)[None]
    s = jnp.where(valid[None, None, :, None], s + bias[None, None, None], -jnp.inf)
    m = jnp.max(s, axis=-1, keepdims=True)
    p = jnp.exp(s - m)
    l = jnp.sum(p, axis=-1, keepdims=True)
    o = jnp.einsum('brnhqk,brnkhd->brnqhd', (p / l).astype(v.dtype), vv)
    lse = (m + jnp.log(l))[..., 0]
    o = o.reshape(B, dilation, Lp, H, Dh)[:, :, :L].transpose(0, 2, 1, 3, 4).reshape(B, S, H, Dh)
    lse = lse.transpose(0, 1, 2, 4, 3).reshape(B, dilation, Lp, H)[:, :, :L]
    lse = lse.transpose(0, 2, 1, 3).reshape(B, S, H)
    return o, lse


def setup_inputs(seed: int = 0) -> dict:
    key = jax.random.key(seed)
    ks = jax.random.split(key, 16)
    f32 = jnp.float32
    nrm = lambda k, shape, fan_in, gain=1.0: jax.random.normal(k, shape, f32) * (gain * fan_in ** -0.5)
    return {
        "x": jax.random.normal(ks[0], (BATCH, SEQ, D_MODEL), f32),
        "c": jax.random.normal(ks[1], (BATCH, D_MODEL), f32),
        "w_ada": nrm(ks[2], (DEPTH, D_MODEL, N_MOD * D_MODEL), D_MODEL, 0.5),
        "b_ada": 0.01 * jax.random.normal(ks[3], (DEPTH, N_MOD * D_MODEL), f32),
        "g_norm1": 1.0 + 0.01 * jax.random.normal(ks[4], (DEPTH, D_MODEL), f32),
        "g_norm2": 1.0 + 0.01 * jax.random.normal(ks[5], (DEPTH, D_MODEL), f32),
        "g_final": 1.0 + 0.01 * jax.random.normal(ks[6], (D_MODEL,), f32),
        "w_in": nrm(ks[7], (DEPTH, D_MODEL, IN_COLS), D_MODEL),
        "b_gate": 0.01 * jax.random.normal(ks[8], (DEPTH, N_BRANCHES * D_MODEL), f32),
        "w_proj_sb": nrm(ks[9], (DEPTH, SB_W, D_MODEL), SB_W),
        "w_proj_dil": nrm(ks[10], (DEPTH, DIL_OUT, D_MODEL), DIL_OUT),
        "w_out": nrm(ks[11], (DEPTH, D_MODEL, D_MODEL), D_MODEL),
        "w_ffn_gate": nrm(ks[12], (DEPTH, D_MODEL, D_FF), D_MODEL),
        "w_ffn_up": nrm(ks[13], (DEPTH, D_MODEL, D_FF), D_MODEL),
        "w_ffn_down": nrm(ks[14], (DEPTH, D_FF, D_MODEL), D_FF),
    }


def reference(x, c, w_ada, b_ada, g_norm1, g_norm2, g_final, w_in, b_gate, w_proj_sb, w_proj_dil,
              w_out, w_ffn_gate, w_ffn_up, w_ffn_down):
    B, S, D = x.shape
    slopes = alibi_slopes().reshape(N_DIL_GROUPS, DIL_HEADS_PER_GROUP)
    split_idx = [int(i) for i in np.cumsum([SB_W] * 3 + [DIL_W] * 3)]
    for l in range(DEPTH):
        mod = jax.nn.silu(c) @ w_ada[l] + b_ada[l]
        shift1, scale1, gate1, shift2, scale2, gate2 = [t[:, None, :] for t in jnp.split(mod, N_MOD, axis=-1)]

        h = rmsnorm(x, g_norm1[l]) * (1.0 + scale1) + shift1
        proj = h @ w_in[l]
        q_sb, k_sb, v_sb, q_dl, k_dl, v_dl, gate_pre = jnp.split(proj, split_idx, axis=-1)

        sb_shape = (B, S, SB_HEADS, HEAD_DIM)
        o_sb = stick_breaking_attention(q_sb.reshape(sb_shape), k_sb.reshape(sb_shape), v_sb.reshape(sb_shape))
        y_sb = o_sb.reshape(B, S, SB_W) @ w_proj_sb[l]

        dl_shape = (B, S, N_DIL_GROUPS, DIL_HEADS_PER_GROUP, HEAD_DIM)
        q_dl, k_dl, v_dl = q_dl.reshape(dl_shape), k_dl.reshape(dl_shape), v_dl.reshape(dl_shape)
        outs, lses = [], []
        for g, (window, dilation) in enumerate(DIL_GROUPS):
            o_g, lse_g = dilated_window_attention(q_dl[:, :, g], k_dl[:, :, g], v_dl[:, :, g],
                                                  slopes[g], window, dilation)
            outs.append(o_g)
            lses.append(lse_g)
        w_mix = jax.nn.softmax(jnp.stack(lses, axis=0), axis=0)
        o_dl = jnp.sum(w_mix[..., None].astype(x.dtype) * jnp.stack(outs, axis=0), axis=0)
        y_dl = o_dl.reshape(B, S, DIL_OUT) @ w_proj_dil[l]

        gates = jax.nn.sigmoid(gate_pre + b_gate[l])
        g_sb, g_dl = jnp.split(gates, N_BRANCHES, axis=-1)
        mixed = (g_sb * y_sb + g_dl * y_dl) @ w_out[l]
        x = x + gate1 * mixed

        h2 = rmsnorm(x, g_norm2[l]) * (1.0 + scale2) + shift2
        ffn = (jax.nn.silu(h2 @ w_ffn_gate[l]) * (h2 @ w_ffn_up[l])) @ w_ffn_down[l]
        x = x + gate2 * ffn
    return rmsnorm(x, g_final)
```

```cpp
#include <hip/hip_runtime.h>
#include <cstdint>
#include <cstdio>

typedef unsigned short bf16;
typedef float f32x4 __attribute__((ext_vector_type(4)));
typedef unsigned u32x4 __attribute__((ext_vector_type(4)));

constexpr int DM = 2048, NB = 4, SEQ = 2048, M = NB * SEQ;
constexpr int HD = 128, SBH = 8;
constexpr int SBW = 1024, DLW = 1536, DLO = 512;
constexpr int INC = 3 * SBW + 3 * DLW + 2 * DM;
constexpr int NQKV = 3 * SBW + 3 * DLW;
constexpr int DFF = 5632;
constexpr int NMOD = 6 * DM;
constexpr float EPS = 1e-6f;
constexpr int C_QSB = 0, C_KSB = 1024, C_VSB = 2048, C_QDL = 3072, C_KDL = 4608, C_VDL = 6144;
constexpr int C_ODL = 1024;
constexpr int KPROJ = SBW + DLO;

constexpr size_t MiB = 1u << 20;
constexpr size_t WS_MOD = 1 * MiB;
constexpr size_t WS_WIN = 8 * MiB;
constexpr size_t WS_WPROJ = 54 * MiB;
constexpr size_t WS_WOUT = 60 * MiB;
constexpr size_t WS_WGU = 68 * MiB;
constexpr size_t WS_WDN = 112 * MiB;
constexpr size_t WS_XN = 134 * MiB;
constexpr size_t WS_QKV = 166 * MiB;
constexpr size_t WS_GATES = 286 * MiB;
constexpr size_t WS_END = 350 * MiB;

__device__ __forceinline__ unsigned f2bf(float f) { unsigned u = __builtin_bit_cast(unsigned, f); return (u + 0x7fffu + ((u >> 16) & 1u)) >> 16; }
__device__ __forceinline__ float bf2f(unsigned short h) { return __builtin_bit_cast(float, (unsigned)h << 16); }
__device__ __forceinline__ float sigmoidf_(float x) { return 1.f / (1.f + __expf(-x)); }
__device__ __forceinline__ float siluf_(float x) { return x / (1.f + __expf(-x)); }

__global__ void k_transpose(const float* __restrict__ W, bf16* __restrict__ Wt, int K, int N, int ldk, int coff, int mode, int pad_) {
    __shared__ float t[32][33];
    const int n0 = blockIdx.x * 32, k0 = blockIdx.y * 32, tx = threadIdx.x & 31, ty = threadIdx.x >> 5;
    for (int i = ty; i < 32; i += 8) t[i][tx] = W[(size_t)(k0 + i) * N + n0 + tx];
    __syncthreads();
    for (int i = ty; i < 32; i += 8) {
        const int n = n0 + i; int row = n;
        if (mode == 1) row = (n >> 7) * 256 + (n & 127); else if (mode == 2) row = (n >> 7) * 256 + 128 + (n & 127);
        Wt[(size_t)row * ldk + coff + k0 + tx] = (bf16)f2bf(t[tx][i]);
    }
}

__global__ void k_mod(const float* __restrict__ c, const float* __restrict__ w, const float* __restrict__ bias, float* __restrict__ mod) {
    __shared__ float sc[NB][DM];
    for (int i = threadIdx.x; i < NB * DM; i += blockDim.x) sc[i / DM][i % DM] = siluf_(c[i]);
    __syncthreads();
    const int n = blockIdx.x * blockDim.x + threadIdx.x;
    float a0 = 0, a1 = 0, a2 = 0, a3 = 0;
    for (int k = 0; k < DM; ++k) { const float wv = w[(size_t)k * NMOD + n]; a0 += sc[0][k] * wv; a1 += sc[1][k] * wv; a2 += sc[2][k] * wv; a3 += sc[3][k] * wv; }
    const float bv = bias[n];
    mod[0 * NMOD + n] = a0 + bv; mod[1 * NMOD + n] = a1 + bv; mod[2 * NMOD + n] = a2 + bv; mod[3 * NMOD + n] = a3 + bv;
}

__device__ __forceinline__ float block_sum(float v, float* red) {
    for (int o = 32; o > 0; o >>= 1) v += __shfl_xor(v, o);
    const int w = threadIdx.x >> 6, nw = blockDim.x >> 6;
    __syncthreads();
    if ((threadIdx.x & 63) == 0) red[w] = v;
    __syncthreads();
    float s = 0; for (int i = 0; i < nw; ++i) s += red[i];
    return s;
}
__device__ __forceinline__ float block_max(float v, float* red) {
    for (int o = 32; o > 0; o >>= 1) v = fmaxf(v, __shfl_xor(v, o));
    const int w = threadIdx.x >> 6, nw = blockDim.x >> 6;
    __syncthreads();
    if ((threadIdx.x & 63) == 0) red[w] = v;
    __syncthreads();
    float s = red[0]; for (int i = 1; i < nw; ++i) s = fmaxf(s, red[i]);
    return s;
}

__global__ void k_norm_mod(const float* __restrict__ x, const float* __restrict__ g, const float* __restrict__ mod, bf16* __restrict__ out, int shift_off, int scale_off) {
    __shared__ float red[8];
    const int row = blockIdx.x, b = row / SEQ;
    const float* xr = x + (size_t)row * DM;
    float v[8]; float ss = 0;
    for (int i = 0; i < 8; ++i) { v[i] = xr[threadIdx.x + 256 * i]; ss += v[i] * v[i]; }
    ss = block_sum(ss, red);
    const float rstd = 1.0f / sqrtf(ss * (1.0f / DM) + EPS);
    for (int i = 0; i < 8; ++i) { const int cidx = threadIdx.x + 256 * i;
        const float y = v[i] * rstd * g[cidx] * (1.0f + mod[b * NMOD + scale_off + cidx]) + mod[b * NMOD + shift_off + cidx];
        out[(size_t)row * DM + cidx] = (bf16)f2bf(y); }
}
__global__ void k_final(float* __restrict__ x, const float* __restrict__ g) {
    __shared__ float red[8];
    const int row = blockIdx.x; float* xr = x + (size_t)row * DM;
    float v[8]; float ss = 0;
    for (int i = 0; i < 8; ++i) { v[i] = xr[threadIdx.x + 256 * i]; ss += v[i] * v[i]; }
    ss = block_sum(ss, red);
    const float rstd = 1.0f / sqrtf(ss * (1.0f / DM) + EPS);
    for (int i = 0; i < 8; ++i) { const int cidx = threadIdx.x + 256 * i; xr[cidx] = v[i] * rstd * g[cidx]; }
}

struct Seg { int akoff, bkoff, klen, browoff; };
template <int NSEG, class Epi>
__global__ void __launch_bounds__(256) k_gemm(const bf16* __restrict__ A, const bf16* __restrict__ Bt, Epi E, Seg s0, Seg s1, int lda, int ldb, int bstride, int pad_) {
    __shared__ float As[16][132], Bs[16][132];
    const int tid = threadIdx.x, tx = tid & 15, ty = tid >> 4;
    const int m0 = blockIdx.y * 128, nb = blockIdx.x;
    float acc[NSEG][8][8];
    for (int s = 0; s < NSEG; ++s) for (int i = 0; i < 8; ++i) for (int j = 0; j < 8; ++j) acc[s][i][j] = 0.f;
    const int lr = tid >> 1, lk = (tid & 1) * 8;
#pragma unroll
    for (int s = 0; s < NSEG; ++s) {
        const Seg sg = s == 0 ? s0 : s1;
        const bf16* Ap = A + (size_t)(m0 + lr) * lda + sg.akoff + lk;
        const bf16* Bp = Bt + (size_t)(nb * bstride + sg.browoff + lr) * ldb + sg.bkoff + lk;
        for (int k0 = 0; k0 < sg.klen; k0 += 16) {
            const u32x4 av = *(const u32x4*)(Ap + k0), bv = *(const u32x4*)(Bp + k0);
            __syncthreads();
#pragma unroll
            for (int i = 0; i < 4; ++i) {
                As[lk + 2 * i][lr] = __builtin_bit_cast(float, av[i] << 16); As[lk + 2 * i + 1][lr] = __builtin_bit_cast(float, av[i] & 0xffff0000u);
                Bs[lk + 2 * i][lr] = __builtin_bit_cast(float, bv[i] << 16); Bs[lk + 2 * i + 1][lr] = __builtin_bit_cast(float, bv[i] & 0xffff0000u);
            }
            __syncthreads();
#pragma unroll
            for (int kk = 0; kk < 16; ++kk) {
                const f32x4 a0 = *(const f32x4*)&As[kk][ty * 8], a1 = *(const f32x4*)&As[kk][ty * 8 + 4];
                const f32x4 b0 = *(const f32x4*)&Bs[kk][tx * 8], b1 = *(const f32x4*)&Bs[kk][tx * 8 + 4];
                const float a[8] = {a0[0], a0[1], a0[2], a0[3], a1[0], a1[1], a1[2], a1[3]};
                const float b[8] = {b0[0], b0[1], b0[2], b0[3], b1[0], b1[1], b1[2], b1[3]};
#pragma unroll
                for (int i = 0; i < 8; ++i)
#pragma unroll
                    for (int j = 0; j < 8; ++j) acc[s][i][j] += a[i] * b[j];
            }
        }
    }
#pragma unroll
    for (int i = 0; i < 8; ++i) E(m0 + ty * 8 + i, nb, tx * 8, acc[0][i], acc[NSEG - 1][i]);
}

struct EpiInProj { bf16* qkv; bf16* gates; const float* bgate;
    __device__ void operator()(int row, int nb, int c0, const float (&a)[8], const float (&)[8]) const {
        const int col = nb * 128 + c0;
        if (col < NQKV) { for (int j = 0; j < 8; ++j) qkv[(size_t)row * NQKV + col + j] = (bf16)f2bf(a[j]); }
        else { const int gc = col - NQKV; for (int j = 0; j < 8; ++j) gates[(size_t)row * 4096 + gc + j] = (bf16)f2bf(sigmoidf_(a[j] + bgate[gc + j])); }
    } };
struct EpiProj { const bf16* gates; bf16* u;
    __device__ void operator()(int row, int nb, int c0, const float (&a)[8], const float (&b)[8]) const {
        const int col = nb * 128 + c0;
        for (int j = 0; j < 8; ++j) { const float gs = bf2f(gates[(size_t)row * 4096 + col + j]), gd = bf2f(gates[(size_t)row * 4096 + 2048 + col + j]);
            u[(size_t)row * DM + col + j] = (bf16)f2bf(gs * a[j] + gd * b[j]); }
    } };
struct EpiRes { const float* base; float* out; const float* mod; int gate_off; int pad;
    __device__ void operator()(int row, int nb, int c0, const float (&a)[8], const float (&)[8]) const {
        const int col = nb * 128 + c0, b = row / SEQ;
        for (int j = 0; j < 8; ++j) out[(size_t)row * DM + col + j] = base[(size_t)row * DM + col + j] + mod[b * NMOD + gate_off + col + j] * a[j];
    } };
struct EpiSwiglu { bf16* a2;
    __device__ void operator()(int row, int nb, int c0, const float (&g)[8], const float (&u)[8]) const {
        const int col = nb * 128 + c0;
        for (int j = 0; j < 8; ++j) a2[(size_t)row * DFF + col + j] = (bf16)f2bf(siluf_(g[j]) * u[j]);
    } };

__global__ void __launch_bounds__(256) k_attn_sb(bf16* __restrict__ qkv) {
    __shared__ float zs[SEQ], sps[SEQ], qf[HD], red[2][HD];
    const int t = blockIdx.x % SEQ, h = (blockIdx.x / SEQ) % SBH, b = blockIdx.x / (SEQ * SBH), tid = threadIdx.x;
    const size_t rowq = (size_t)(b * SEQ + t) * NQKV;
    if (tid < HD) qf[tid] = bf2f(qkv[rowq + C_QSB + h * HD + tid]);
    __syncthreads();
    const float scale = 0.08838834764831845f;
    for (int s = tid; s < t; s += 256) {
        const bf16* kr = qkv + (size_t)(b * SEQ + s) * NQKV + C_KSB + h * HD;
        float z = 0;
        for (int d0 = 0; d0 < HD; d0 += 8) { const u32x4 kv = *(const u32x4*)(kr + d0);
            for (int i = 0; i < 4; ++i) { z += qf[d0 + 2 * i] * __builtin_bit_cast(float, kv[i] << 16) + qf[d0 + 2 * i + 1] * __builtin_bit_cast(float, kv[i] & 0xffff0000u); } }
        z *= scale; zs[s] = z; sps[s] = fmaxf(z, 0.f) + log1pf(__expf(-fabsf(z)));
    }
    __syncthreads();
    if (tid == 0) { float run = 0.f; for (int s = t - 1; s >= 0; --s) { run += sps[s]; zs[s] = __expf(zs[s] - run); } }
    __syncthreads();
    const int d = tid & 127, half = tid >> 7; float o = 0.f;
    for (int s = half; s < t; s += 2) o += zs[s] * bf2f(qkv[(size_t)(b * SEQ + s) * NQKV + C_VSB + h * HD + d]);
    red[half][d] = o;
    __syncthreads();
    if (tid < HD) qkv[rowq + C_QSB + h * HD + tid] = (bf16)f2bf(red[0][tid] + red[1][tid]);
}

__global__ void __launch_bounds__(256) k_attn_dil(bf16* __restrict__ qkv) {
    __shared__ float qf[HD], ps[256], red8[8], red[2][HD];
    const int jh = blockIdx.x & 3, t = (blockIdx.x >> 2) % SEQ, b = blockIdx.x / (4 * SEQ), tid = threadIdx.x;
    const size_t rowq = (size_t)(b * SEQ + t) * NQKV;
    const float scale = 0.08838834764831845f;
    float og[3] = {0.f, 0.f, 0.f}, lse[3];
#pragma unroll
    for (int g = 0; g < 3; ++g) {
        const int dil = g == 0 ? 1 : (g == 1 ? 4 : 16);
        const int i = t / dil, nk = (i < 128 ? i : 128) + 1;
        const float slope = exp2f(-8.0f * (float)(g * 4 + jh + 1) / 12.0f);
        __syncthreads();
        if (tid < HD) qf[tid] = bf2f(qkv[rowq + C_QDL + g * 512 + jh * HD + tid]);
        __syncthreads();
        float sc = -INFINITY;
        if (tid < nk) {
            const bf16* kr = qkv + (size_t)(b * SEQ + t - tid * dil) * NQKV + C_KDL + g * 512 + jh * HD;
            float z = 0;
            for (int d0 = 0; d0 < HD; d0 += 8) { const u32x4 kv = *(const u32x4*)(kr + d0);
                for (int k = 0; k < 4; ++k) { z += qf[d0 + 2 * k] * __builtin_bit_cast(float, kv[k] << 16) + qf[d0 + 2 * k + 1] * __builtin_bit_cast(float, kv[k] & 0xffff0000u); } }
            sc = z * scale - slope * (float)(dil * tid);
        }
        const float mx = block_max(sc, red8);
        const float p = tid < nk ? __expf(sc - mx) : 0.f;
        const float l = block_sum(p, red8);
        ps[tid] = p / l;
        __syncthreads();
        lse[g] = mx + logf(l);
        const int d = tid & 127, half = tid >> 7; float o = 0.f;
        for (int r = half; r < nk; r += 2) o += ps[r] * bf2f(qkv[(size_t)(b * SEQ + t - r * dil) * NQKV + C_VDL + g * 512 + jh * HD + d]);
        red[half][d] = o;
        __syncthreads();
        if (tid < HD) og[g] = red[0][tid] + red[1][tid];
    }
    const float mm = fmaxf(lse[0], fmaxf(lse[1], lse[2]));
    const float w0 = __expf(lse[0] - mm), w1 = __expf(lse[1] - mm), w2 = __expf(lse[2] - mm), ws = w0 + w1 + w2;
    if (tid < HD) qkv[rowq + C_ODL + jh * HD + tid] = (bf16)f2bf((w0 * og[0] + w1 * og[1] + w2 * og[2]) / ws);
}

extern "C" void kernel_launch(void* const* d_in, const int* in_sizes, int n_in, void* d_out, int out_size, void* d_ws, size_t ws_size, hipStream_t stream) {
    const float* x = (const float*)d_in[0]; const float* c = (const float*)d_in[1]; const float* w_ada = (const float*)d_in[2]; const float* b_ada = (const float*)d_in[3];
    const float* g1 = (const float*)d_in[4]; const float* g2 = (const float*)d_in[5]; const float* gf = (const float*)d_in[6]; const float* w_in = (const float*)d_in[7];
    const float* b_gate = (const float*)d_in[8]; const float* w_psb = (const float*)d_in[9]; const float* w_pdl = (const float*)d_in[10]; const float* w_out = (const float*)d_in[11];
    const float* w_fg = (const float*)d_in[12]; const float* w_fu = (const float*)d_in[13]; const float* w_fd = (const float*)d_in[14];
    if (ws_size < WS_END) { fprintf(stderr, "workspace too small\n"); return; }
    unsigned char* ws = (unsigned char*)d_ws; float* out = (float*)d_out;
    float* mod = (float*)(ws + WS_MOD);
    bf16 *win = (bf16*)(ws + WS_WIN), *wproj = (bf16*)(ws + WS_WPROJ), *wout = (bf16*)(ws + WS_WOUT), *wgu = (bf16*)(ws + WS_WGU), *wdn = (bf16*)(ws + WS_WDN);
    bf16 *xn = (bf16*)(ws + WS_XN), *qkv = (bf16*)(ws + WS_QKV), *gates = (bf16*)(ws + WS_GATES);
    k_transpose<<<dim3(INC / 32, DM / 32), 256, 0, stream>>>(w_in, win, DM, INC, DM, 0, 0, 0);
    k_transpose<<<dim3(DM / 32, SBW / 32), 256, 0, stream>>>(w_psb, wproj, SBW, DM, KPROJ, 0, 0, 0);
    k_transpose<<<dim3(DM / 32, DLO / 32), 256, 0, stream>>>(w_pdl, wproj, DLO, DM, KPROJ, SBW, 0, 0);
    k_transpose<<<dim3(DM / 32, DM / 32), 256, 0, stream>>>(w_out, wout, DM, DM, DM, 0, 0, 0);
    k_transpose<<<dim3(DFF / 32, DM / 32), 256, 0, stream>>>(w_fg, wgu, DM, DFF, DM, 0, 1, 0);
    k_transpose<<<dim3(DFF / 32, DM / 32), 256, 0, stream>>>(w_fu, wgu, DM, DFF, DM, 0, 2, 0);
    k_transpose<<<dim3(DM / 32, DFF / 32), 256, 0, stream>>>(w_fd, wdn, DFF, DM, DFF, 0, 0, 0);
    k_mod<<<NMOD / 256, 256, 0, stream>>>(c, w_ada, b_ada, mod);
    k_norm_mod<<<M, 256, 0, stream>>>(x, g1, mod, xn, 0, DM);
    { Seg s{0, 0, DM, 0}; k_gemm<1, EpiInProj><<<dim3(INC / 128, M / 128), 256, 0, stream>>>(xn, win, EpiInProj{qkv, gates, b_gate}, s, s, DM, DM, 128, 0); }
    k_attn_sb<<<NB * SBH * SEQ, 256, 0, stream>>>(qkv);
    k_attn_dil<<<NB * SEQ * 4, 256, 0, stream>>>(qkv);
    { Seg s0{0, 0, SBW, 0}, s1{SBW, SBW, DLO, 0}; k_gemm<2, EpiProj><<<dim3(DM / 128, M / 128), 256, 0, stream>>>(qkv, wproj, EpiProj{gates, xn}, s0, s1, NQKV, KPROJ, 128, 0); }
    { Seg s{0, 0, DM, 0}; k_gemm<1, EpiRes><<<dim3(DM / 128, M / 128), 256, 0, stream>>>(xn, wout, EpiRes{x, out, mod, 2 * DM, 0}, s, s, DM, DM, 128, 0); }
    k_norm_mod<<<M, 256, 0, stream>>>(out, g2, mod, xn, 3 * DM, 4 * DM);
    { Seg s0{0, 0, DM, 0}, s1{0, 0, DM, 128}; k_gemm<2, EpiSwiglu><<<dim3(DFF / 128, M / 128), 256, 0, stream>>>(xn, wgu, EpiSwiglu{qkv}, s0, s1, DM, DM, 256, 0); }
    { Seg s{0, 0, DFF, 0}; k_gemm<1, EpiRes><<<dim3(DM / 128, M / 128), 256, 0, stream>>>(qkv, wdn, EpiRes{out, out, mod, 5 * DM, 0}, s, s, DFF, DFF, 128, 0); }
    k_final<<<M, 256, 0, stream>>>(out, gf);
}
```

```cpp
#include <hip/hip_runtime.h>
#include <cstdint>
#include <cstdio>

typedef unsigned short bf16;
typedef float f32x4 __attribute__((ext_vector_type(4)));
typedef float f32x16 __attribute__((ext_vector_type(16)));
typedef unsigned u32x4 __attribute__((ext_vector_type(4)));
typedef unsigned u32x2 __attribute__((ext_vector_type(2)));
typedef short bf16x8 __attribute__((ext_vector_type(8)));
typedef short s16x4 __attribute__((ext_vector_type(4)));
#define LAS __attribute__((address_space(3)))

constexpr int DM = 2048, NB = 4, SEQ = 2048, M = NB * SEQ;
constexpr int HD = 128, SBH = 8;
constexpr int SBW = 1024, DLW = 1536, DLO = 512;
constexpr int INC = 3 * SBW + 3 * DLW + 2 * DM;
constexpr int NQKV = 3 * SBW + 3 * DLW;
constexpr int DFF = 5632;
constexpr int NMOD = 6 * DM;
constexpr float EPS = 1e-6f;
constexpr int C_QSB = 0, C_KSB = 1024, C_VSB = 2048, C_QDL = 3072, C_KDL = 4608, C_VDL = 6144;
constexpr int C_ODL = 1024;
constexpr int KPROJ = SBW + DLO;
constexpr float QSCALE = 0.08838834764831845f * 1.4426950408889634f;
constexpr float LOG2E = 1.4426950408889634f;

constexpr size_t MiB = 1u << 20;
constexpr size_t WS_CTL = 0, CTL_ZERO_BYTES = 64 * 1024;
constexpr size_t WS_MOD = 1 * MiB;
constexpr size_t WS_LSE = 2 * MiB;
constexpr size_t WS_WIN = 8 * MiB;
constexpr size_t WS_WPROJ = 54 * MiB;
constexpr size_t WS_WOUT = 60 * MiB;
constexpr size_t WS_WGU = 68 * MiB;
constexpr size_t WS_WDN = 112 * MiB;
constexpr size_t WS_XN = 134 * MiB;
constexpr size_t WS_QKV = 166 * MiB;
constexpr size_t WS_GATES = 286 * MiB;
constexpr size_t WS_END = 350 * MiB;

__device__ __forceinline__ unsigned f2bf(float f) { unsigned u = __builtin_bit_cast(unsigned, f); return (u + 0x7fffu + ((u >> 16) & 1u)) >> 16; }
__device__ __forceinline__ float bf2f(unsigned short h) { return __builtin_bit_cast(float, (unsigned)h << 16); }
__device__ __forceinline__ float sigmoidf_(float x) { return 1.f / (1.f + __expf(-x)); }
__device__ __forceinline__ float siluf_(float x) { return x / (1.f + __expf(-x)); }
typedef float f32x2_t __attribute__((ext_vector_type(2))); typedef __bf16 bf16x2_t __attribute__((ext_vector_type(2)));
__device__ __forceinline__ unsigned cvtpk(float lo, float hi) { f32x2_t v = {lo, hi}; bf16x2_t b = __builtin_convertvector(v, bf16x2_t); return __builtin_bit_cast(unsigned, b); }
__device__ __forceinline__ float blo(unsigned u) { return __builtin_bit_cast(float, u << 16); }
__device__ __forceinline__ float bhi(unsigned u) { return __builtin_bit_cast(float, u & 0xffff0000u); }


namespace pg8 {
#define PG8_LAS __attribute__((address_space(3)))
typedef unsigned short bf16_t;
constexpr int BM = 256, BK = 64, HALF = 128, HTB = HALF * BK * 2  , STAGE_BYTES = 8 * HTB, NXCD = 8, WGM = 8;
__host__ __device__ __forceinline__ int lds_byte(int r, int c) { const int st = (r >> 4) * 2 + (c >> 5), rr = r & 15, cc = c & 31, ob = rr * 64 + cc * 2; return st * 1024 + (ob ^ (((ob >> 9) & 1) << 5)); }
__host__ __device__ __forceinline__ void stage_rc(int b, int& R, int& C) { const int st = b / 1024, sb = b % 1024, swz = sb ^ (((sb >> 9) & 1) << 5); R = (st >> 1) * 16 + swz / 64; C = (st & 1) * 32 + (swz % 64) / 2; }
__host__ __device__ __forceinline__ int perm32(int rho) { const int n = rho >> 4, i = rho & 15; return 8 * (i >> 2) + 4 * n + (i & 3); }
struct Unit { int pm, pn; };
struct Gemm { const bf16_t* A; const bf16_t* Bt; int lda, ldb, K; };
struct StaticOrder {
    int nM, nN, nwg, G, c;
    __host__ __device__ void init(int M_, int N_, int G_, int c_) { nM = M_ / BM; nN = N_ / BM; nwg = nM * nN; G = G_; c = c_; }
    __host__ __device__ bool next(int i, Unit& u) const {
        const long L = (long)i * G + c; if (L >= nwg) return false;
        int wgid = (int)L; { const int q = nwg / NXCD, r = nwg % NXCD, xcd = wgid % NXCD, off = wgid / NXCD; wgid = (xcd < r ? xcd * (q + 1) : r * (q + 1) + (xcd - r) * q) + off; }
        const int nig = WGM * nN, gid = wgid / nig, fm = gid * WGM, gsz = (nM - fm) < WGM ? (nM - fm) : WGM;
        u.pm = fm + ((wgid % nig) % gsz); u.pn = (wgid % nig) / gsz; return true;
    }
    __device__ __forceinline__ void a_ready(const Unit&) const {}
    __device__ __forceinline__ void done(const Unit&) const {}
};
template <class Epi, class Sched, bool ALIGN_EPI = false, bool SP2 = false>
__device__ __forceinline__ void gemm_phase(PG8_LAS unsigned char* lds, const Gemm g, const Sched& S, const Epi& E) {
    int tid_ = threadIdx.x; asm volatile("" : "+v"(tid_));
    const int tid = tid_, wid = __builtin_amdgcn_readfirstlane(tid >> 6), lane = tid & 63, wr = wid >> 2, wc = wid & 3, fr = lane & 15, fq = lane >> 4;
    const int K = g.K, nt = K / BK;
    unsigned voffA[2], voffB[2];
#pragma unroll
    for (int i = 0; i < 2; ++i) { int R, C; stage_rc(tid * 16 + i * 8192, R, C); const int Rb = Epi::PERM ? ((R & ~31) + perm32(R & 31)) : R;
        voffA[i] = (unsigned)(R * g.lda + C) * 2u; voffB[i] = (unsigned)(Rb * g.ldb + C) * 2u; }
    const size_t kstep = (size_t)(BK * 2);
    const size_t hstepA = (size_t)HALF * g.lda * 2, hstepB = (size_t)HALF * g.ldb * 2;
    const size_t tstepA = 2 * hstepA, tstepB = 2 * hstepB;
    const unsigned ldsw = (unsigned)wid * 1024u;
    const int aoff = lds_byte(wr * 64 + fr, fq * 8), boff = lds_byte(wc * 32 + fr, fq * 8);
#define PG8_SA(b, h) (((b) * 2 + (h)) * HTB)
#define PG8_SB(b, h) ((4 + (b) * 2 + (h)) * HTB)
#define PG8_STAGE(bufoff, gbase, voff) do { _Pragma("unroll") for (int _i = 0; _i < 2; ++_i) \
        __builtin_amdgcn_global_load_lds((const unsigned*)((const char*)(gbase) + (voff)[_i]), (PG8_LAS unsigned*)(lds + (bufoff) + ldsw + _i * 8192), 16, 0, 0); } while (0)
#define PG8_LDA(dst, b, h) do { _Pragma("unroll") for (int m = 0; m < 4; ++m) _Pragma("unroll") for (int k = 0; k < 2; ++k) dst[m][k] = *(const PG8_LAS bf16x8*)(lds + PG8_SA(b, h) + aoff + m * 2048 + k * 1024); } while (0)
#define PG8_LDB(dst, b, h) do { _Pragma("unroll") for (int n = 0; n < 2; ++n) _Pragma("unroll") for (int k = 0; k < 2; ++k) dst[n][k] = *(const PG8_LAS bf16x8*)(lds + PG8_SB(b, h) + boff + n * 2048 + k * 1024); } while (0)
#define PG8_MMA(ai, bj, At, Bt) do { __builtin_amdgcn_s_setprio(1); _Pragma("unroll") for (int m = 0; m < 4; ++m) _Pragma("unroll") for (int n = 0; n < 2; ++n) _Pragma("unroll") for (int k = 0; k < 2; ++k) \
        acc[ai][bj][m][n] = __builtin_amdgcn_mfma_f32_16x16x32_bf16(Bt[n][k], At[m][k], acc[ai][bj][m][n], 0, 0, 0); __builtin_amdgcn_s_setprio(0); } while (0)
#define PG8_WAIT_V(n) asm volatile("s_waitcnt vmcnt(" #n ")" ::: "memory")
#define PG8_WAIT_L(n) asm volatile("s_waitcnt lgkmcnt(" #n ")" ::: "memory")
#define PG8_BAR __builtin_amdgcn_s_barrier()
#define PG8_SCHED __builtin_amdgcn_sched_barrier(0)
    Unit cur, nxt; int ui = 0;
    if (!S.next(0, cur)) return;
    f32x4 acc[2][2][4][2];
#pragma unroll
    for (int a = 0; a < 2; ++a)
#pragma unroll
        for (int b = 0; b < 2; ++b)
#pragma unroll
            for (int m = 0; m < 4; ++m)
#pragma unroll
                for (int n = 0; n < 2; ++n) acc[a][b][m][n] = (f32x4){0.f, 0.f, 0.f, 0.f};
    bf16x8 At[4][2], B0[2][2], B1[2][2];
    const char* cA = (const char*)g.A + (size_t)cur.pm * tstepA; const char* cB = (const char*)g.Bt + (size_t)cur.pn * tstepB;
    S.a_ready(cur);
    if constexpr (SP2) {
        PG8_STAGE(PG8_SB(0, 0), cB, voffB); PG8_STAGE(PG8_SB(0, 1), cB + hstepB, voffB); PG8_STAGE(PG8_SA(0, 0), cA, voffA); PG8_STAGE(PG8_SA(0, 1), cA + hstepA, voffA);
        if (wr == 1) PG8_BAR;
        PG8_WAIT_V(2); PG8_BAR;
        PG8_STAGE(PG8_SB(1, 0), cB + kstep, voffB); PG8_STAGE(PG8_SA(1, 0), cA + kstep, voffA); PG8_STAGE(PG8_SB(1, 1), cB + hstepB + kstep, voffB);
        PG8_WAIT_V(6); PG8_BAR;
    } else {
        PG8_STAGE(PG8_SB(0, 0), cB, voffB); PG8_STAGE(PG8_SA(0, 0), cA, voffA); PG8_STAGE(PG8_SB(0, 1), cB + hstepB, voffB); PG8_STAGE(PG8_SA(0, 1), cA + hstepA, voffA);
        if (wr == 1) PG8_BAR;
        PG8_WAIT_V(4); PG8_BAR;
        PG8_STAGE(PG8_SB(1, 0), cB + kstep, voffB); PG8_STAGE(PG8_SA(1, 0), cA + kstep, voffA); PG8_STAGE(PG8_SB(1, 1), cB + hstepB + kstep, voffB);
        PG8_WAIT_V(6); PG8_BAR;
    }
    for (;;) {
        const bool has_next = S.next(ui + 1, nxt);
        const char* nA = has_next ? (const char*)g.A + (size_t)nxt.pm * tstepA : cA; const char* nB = has_next ? (const char*)g.Bt + (size_t)nxt.pn * tstepB : cB;
        for (int t = 0; t < nt; t += 2) {
            const bool last = (t == nt - 2);
            const char* a1 = cA + (size_t)(t + 1) * kstep;
            const char* a2 = last ? nA : cA + (size_t)(t + 2) * kstep; const char* b2 = last ? nB : cB + (size_t)(t + 2) * kstep;
            const char* a3 = a2 + kstep; const char* b3 = b2 + kstep;
            if constexpr (Epi::MID_T > 0) { if (t == Epi::MID_T) E.mid(acc, cur, wr, wc, fr, fq); }
            if (last && has_next) S.a_ready(nxt);
            if constexpr (SP2) {
            PG8_LDB(B0, 0, 0); PG8_LDB(B1, 0, 1); PG8_SCHED; PG8_LDA(At, 0, 0); PG8_STAGE(PG8_SA(1, 1), a1 + hstepA, voffA);
            PG8_WAIT_V(8); PG8_WAIT_L(0); PG8_BAR; PG8_MMA(0, 0, At, B0); PG8_MMA(0, 1, At, B1); PG8_BAR; PG8_SCHED;
            PG8_LDA(At, 0, 1); PG8_STAGE(PG8_SB(0, 0), b2, voffB); PG8_STAGE(PG8_SB(0, 1), b2 + hstepB, voffB); PG8_STAGE(PG8_SA(0, 0), a2, voffA);
            PG8_WAIT_V(8); PG8_WAIT_L(0); PG8_BAR; PG8_MMA(1, 0, At, B0); PG8_MMA(1, 1, At, B1); PG8_BAR; PG8_SCHED;
            PG8_LDB(B0, 1, 0); PG8_LDB(B1, 1, 1); PG8_SCHED; PG8_LDA(At, 1, 0); PG8_STAGE(PG8_SA(0, 1), a2 + hstepA, voffA);
            PG8_WAIT_V(8); PG8_WAIT_L(0); PG8_BAR; PG8_MMA(0, 0, At, B0); PG8_MMA(0, 1, At, B1); PG8_BAR; PG8_SCHED;
            PG8_LDA(At, 1, 1); PG8_STAGE(PG8_SB(1, 0), b3, voffB); PG8_STAGE(PG8_SB(1, 1), b3 + hstepB, voffB); PG8_STAGE(PG8_SA(1, 0), a3, voffA);
            PG8_WAIT_V(8); PG8_WAIT_L(0); PG8_BAR; PG8_MMA(1, 0, At, B0); PG8_MMA(1, 1, At, B1); PG8_BAR; PG8_SCHED;
            } else {
            PG8_LDB(B0, 0, 0); PG8_SCHED; PG8_LDA(At, 0, 0); PG8_STAGE(PG8_SA(1, 1), a1 + hstepA, voffA);
            PG8_WAIT_L(8); PG8_BAR; PG8_WAIT_L(0); PG8_MMA(0, 0, At, B0); PG8_BAR; PG8_SCHED;
            PG8_LDB(B1, 0, 1); PG8_STAGE(PG8_SB(0, 0), b2, voffB);
            PG8_BAR; PG8_WAIT_L(0); PG8_MMA(0, 1, At, B1); PG8_BAR;
            PG8_LDA(At, 0, 1); PG8_STAGE(PG8_SA(0, 0), a2, voffA);
            PG8_BAR; PG8_WAIT_L(0); PG8_MMA(1, 0, At, B0); PG8_BAR; PG8_SCHED;
            PG8_STAGE(PG8_SB(0, 1), b2 + hstepB, voffB);
            PG8_WAIT_V(6); PG8_BAR; PG8_MMA(1, 1, At, B1); PG8_BAR;
            PG8_LDB(B0, 1, 0); PG8_SCHED; PG8_LDA(At, 1, 0); PG8_STAGE(PG8_SA(0, 1), a2 + hstepA, voffA);
            PG8_WAIT_L(8); PG8_BAR; PG8_WAIT_L(0); PG8_MMA(0, 0, At, B0); PG8_BAR; PG8_SCHED;
            PG8_LDB(B1, 1, 1); PG8_STAGE(PG8_SB(1, 0), b3, voffB);
            PG8_BAR; PG8_WAIT_L(0); PG8_MMA(0, 1, At, B1); PG8_BAR;
            PG8_LDA(At, 1, 1); PG8_STAGE(PG8_SA(1, 0), a3, voffA);
            PG8_BAR; PG8_WAIT_L(0); PG8_MMA(1, 0, At, B0); PG8_BAR; PG8_SCHED;
            PG8_STAGE(PG8_SB(1, 1), b3 + hstepB, voffB);
            PG8_WAIT_V(6); PG8_BAR; PG8_MMA(1, 1, At, B1); PG8_BAR;
            }
        }
        if constexpr (ALIGN_EPI) { if (wr == 0) PG8_BAR; }
        if constexpr (!Epi::AFTER_DRAIN) { E(acc, cur, wr, wc, fr, fq); S.done(cur); }
        if (!has_next) break;
#pragma unroll
        for (int a = 0; a < 2; ++a)
#pragma unroll
            for (int b = 0; b < 2; ++b)
#pragma unroll
                for (int m = 0; m < 4; ++m)
#pragma unroll
                    for (int n = 0; n < 2; ++n) acc[a][b][m][n] = (f32x4){0.f, 0.f, 0.f, 0.f};
        cur = nxt; cA = nA; cB = nB; ++ui;
        if constexpr (ALIGN_EPI) { if (wr == 1) PG8_BAR; }
    }
    PG8_WAIT_V(0);
    if constexpr (!ALIGN_EPI) { if (wr == 0) PG8_BAR; }
    PG8_BAR;
    if constexpr (Epi::AFTER_DRAIN) { E.fused(acc, cur, wr, wc, fr, fq, lds, wid, lane); S.done(cur); }
#undef PG8_SA
#undef PG8_SB
#undef PG8_STAGE
#undef PG8_LDA
#undef PG8_LDB
#undef PG8_MMA
#undef PG8_WAIT_V
#undef PG8_WAIT_L
#undef PG8_BAR
#undef PG8_SCHED
}
}

typedef f32x4 AccT[2][2][4][2];
struct EpiInProj {
    static constexpr bool PERM = true, AFTER_DRAIN = false; static constexpr int MID_T = 0;
    bf16* qkv; bf16* gates; const float* bgate;
    __device__ __forceinline__ void operator()(const AccT& acc, const pg8::Unit& u, int wr, int wc, int fr, int fq) const {
        const int row0 = u.pm * 256 + wr * 64 + fr, ct = u.pn * 256;
        if (ct < NQKV) {
            const float sc = (u.pn < 4 || (u.pn >= 12 && u.pn < 18)) ? QSCALE : 1.0f;
            bf16* base = qkv + ct + wc * 32 + 8 * fq;
#pragma unroll
            for (int ai = 0; ai < 2; ++ai)
#pragma unroll
                for (int m = 0; m < 4; ++m) { bf16* rowp = base + (size_t)(row0 + ai * 128 + m * 16) * NQKV;
#pragma unroll
                    for (int bj = 0; bj < 2; ++bj) { const f32x4 v0 = acc[ai][bj][m][0] * sc, v1 = acc[ai][bj][m][1] * sc;
                        u32x4 w; w.x = cvtpk(v0[0], v0[1]); w.y = cvtpk(v0[2], v0[3]); w.z = cvtpk(v1[0], v1[1]); w.w = cvtpk(v1[2], v1[3]);
                        *(u32x4*)(rowp + bj * 128) = w; } }
        } else {
            const int gc = ct - NQKV + wc * 32 + 8 * fq;
            f32x4 bv[2][2];
#pragma unroll
            for (int bj = 0; bj < 2; ++bj)
#pragma unroll
                for (int n = 0; n < 2; ++n) bv[bj][n] = *(const f32x4*)(bgate + gc + bj * 128 + 4 * n);
            bf16* base = gates + gc;
#pragma unroll
            for (int ai = 0; ai < 2; ++ai)
#pragma unroll
                for (int m = 0; m < 4; ++m) { bf16* rowp = base + (size_t)(row0 + ai * 128 + m * 16) * 4096;
#pragma unroll
                    for (int bj = 0; bj < 2; ++bj) { f32x4 v0 = acc[ai][bj][m][0] + bv[bj][0], v1 = acc[ai][bj][m][1] + bv[bj][1];
#pragma unroll
                        for (int e = 0; e < 4; ++e) { v0[e] = __builtin_amdgcn_rcpf(1.0f + __expf(-v0[e])); v1[e] = __builtin_amdgcn_rcpf(1.0f + __expf(-v1[e])); }
                        u32x4 w; w.x = cvtpk(v0[0], v0[1]); w.y = cvtpk(v0[2], v0[3]); w.z = cvtpk(v1[0], v1[1]); w.w = cvtpk(v1[2], v1[3]);
                        *(u32x4*)(rowp + bj * 128) = w; } }
        }
    }
};
struct EpiProjGate {
    static constexpr bool PERM = true, AFTER_DRAIN = false; static constexpr int MID_T = 16;
    const bf16* gates; bf16* U;
    __device__ __forceinline__ void mid(AccT& acc, const pg8::Unit& u, int wr, int wc, int fr, int fq) const {
        unsigned off = (unsigned)((u.pm * 256 + wr * 64 + fr) * 4096 + u.pn * 256 + wc * 32 + 8 * fq) * 2u;
        asm volatile("" : "+v"(off));
        const char* gb = (const char*)gates;
#pragma unroll
        for (int ai = 0; ai < 2; ++ai)
#pragma unroll
            for (int m = 0; m < 4; ++m)
#pragma unroll
                for (int bj = 0; bj < 2; ++bj) { const unsigned o2 = off + (unsigned)((ai * 128 + m * 16) * 4096 + bj * 128) * 2u;
                    const u32x4 gs = *(const u32x4*)(gb + o2), gd = *(const u32x4*)(gb + o2 + 4096u);
#pragma unroll
                    for (int e = 0; e < 4; ++e) { const float r0 = blo(gs[e]) * __builtin_amdgcn_rcpf(fmaxf(blo(gd[e]), 1e-30f)), r1 = bhi(gs[e]) * __builtin_amdgcn_rcpf(fmaxf(bhi(gd[e]), 1e-30f));
                        acc[ai][bj][m][e >> 1][(e & 1) * 2] *= r0; acc[ai][bj][m][e >> 1][(e & 1) * 2 + 1] *= r1; }
                    asm volatile("" ::: "memory"); }
    }
    __device__ __forceinline__ void operator()(const AccT& acc, const pg8::Unit& u, int wr, int wc, int fr, int fq) const {
        const int row0 = u.pm * 256 + wr * 64 + fr, col0 = u.pn * 256 + wc * 32 + 8 * fq;
#pragma unroll
        for (int ai = 0; ai < 2; ++ai)
#pragma unroll
            for (int m = 0; m < 4; ++m) { const size_t roff = (size_t)(row0 + ai * 128 + m * 16);
#pragma unroll
                for (int bj = 0; bj < 2; ++bj) { const u32x4 gd = *(const u32x4*)(gates + roff * 4096 + 2048 + col0 + bj * 128);
                    const f32x4 v0 = acc[ai][bj][m][0], v1 = acc[ai][bj][m][1];
                    u32x4 w; w.x = cvtpk(v0[0] * fmaxf(blo(gd[0]), 1e-30f), v0[1] * fmaxf(bhi(gd[0]), 1e-30f)); w.y = cvtpk(v0[2] * fmaxf(blo(gd[1]), 1e-30f), v0[3] * fmaxf(bhi(gd[1]), 1e-30f));
                    w.z = cvtpk(v1[0] * fmaxf(blo(gd[2]), 1e-30f), v1[1] * fmaxf(bhi(gd[2]), 1e-30f)); w.w = cvtpk(v1[2] * fmaxf(blo(gd[3]), 1e-30f), v1[3] * fmaxf(bhi(gd[3]), 1e-30f));
                    *(u32x4*)(U + roff * DM + col0 + bj * 128) = w; }
                if (m & 1) asm volatile("" ::: "memory"); }
    }
};
struct EpiRes {
    static constexpr bool PERM = false, AFTER_DRAIN = false; static constexpr int MID_T = 0;
    const float* base; float* out; const float* gate;
    __device__ __forceinline__ void operator()(const AccT& acc, const pg8::Unit& u, int wr, int wc, int fr, int fq) const {
        const int row0 = u.pm * 256 + wr * 64 + fr, col0 = u.pn * 256 + wc * 32 + 4 * fq, b = u.pm >> 3;
        f32x4 gv[2][2];
#pragma unroll
        for (int bj = 0; bj < 2; ++bj)
#pragma unroll
            for (int n = 0; n < 2; ++n) gv[bj][n] = *(const f32x4*)(gate + b * NMOD + col0 + bj * 128 + n * 16);
#pragma unroll
        for (int ai = 0; ai < 2; ++ai)
#pragma unroll
            for (int m = 0; m < 4; ++m) { const size_t off = (size_t)(row0 + ai * 128 + m * 16) * DM + col0;
#pragma unroll
                for (int bj = 0; bj < 2; ++bj)
#pragma unroll
                    for (int n = 0; n < 2; ++n) { const f32x4 bs = *(const f32x4*)(base + off + bj * 128 + n * 16); *(f32x4*)(out + off + bj * 128 + n * 16) = bs + gv[bj][n] * acc[ai][bj][m][n]; }
                if (m & 1) asm volatile("" ::: "memory"); }
    }
};
struct EpiSwiglu {
    static constexpr bool PERM = true, AFTER_DRAIN = false; static constexpr int MID_T = 0;
    bf16* a2;
    __device__ __forceinline__ void operator()(const AccT& acc, const pg8::Unit& u, int wr, int wc, int fr, int fq) const {
        const int row0 = u.pm * 256 + wr * 64 + fr, col0 = u.pn * 128 + wc * 32 + 8 * fq;
#pragma unroll
        for (int ai = 0; ai < 2; ++ai)
#pragma unroll
            for (int m = 0; m < 4; ++m) { f32x4 h0, h1;
#pragma unroll
                for (int e = 0; e < 4; ++e) { const float g0 = acc[ai][0][m][0][e], g1 = acc[ai][0][m][1][e];
                    h0[e] = g0 * __builtin_amdgcn_rcpf(1.0f + __expf(-g0)) * acc[ai][1][m][0][e]; h1[e] = g1 * __builtin_amdgcn_rcpf(1.0f + __expf(-g1)) * acc[ai][1][m][1][e]; }
                u32x4 w; w.x = cvtpk(h0[0], h0[1]); w.y = cvtpk(h0[2], h0[3]); w.z = cvtpk(h1[0], h1[1]); w.w = cvtpk(h1[2], h1[3]);
                *(u32x4*)(a2 + (size_t)(row0 + ai * 128 + m * 16) * DFF + col0) = w; }
    }
};

#define XB_TMO      128
#define XB_XCNT(j)  (256  + 64 * (j))
#define XB_XSUB(j)  (1280 + 64 * (j))
#define XB_XGEN(j)  (2304 + 64 * (j))
#define XB_TOP      3328
#define XB_TOPGEN   3392
#define XCD_BAR_WORDS 3456
#define XB_SPIN_CAP (1u << 18)
__device__ __forceinline__ unsigned xb_ld(unsigned* p)              { return __hip_atomic_load(p, __ATOMIC_RELAXED, __HIP_MEMORY_SCOPE_AGENT); }
__device__ __forceinline__ unsigned xb_add(unsigned* p, unsigned v) { return __hip_atomic_fetch_add(p, v, __ATOMIC_RELAXED, __HIP_MEMORY_SCOPE_AGENT); }
__device__ __forceinline__ unsigned xb_xcc_id() { return (unsigned)__builtin_amdgcn_s_getreg((3 << 11) | 20) & 0xFu; }
#define XB_SPIN(cond, bar) do { unsigned _sp = 0; while (cond) { __builtin_amdgcn_s_sleep(1); \
    if ((++_sp & 255u) == 0u) { if (xb_ld(&(bar)[XB_TMO])) break; if (_sp > XB_SPIN_CAP) { atomicAdd(&(bar)[XB_TMO], 1u); break; } } } } while (0)
struct XcdBarrier { unsigned* bar; unsigned x; volatile LAS unsigned* st; };
__device__ __forceinline__ XcdBarrier xcd_barrier_post(unsigned* bar, volatile LAS unsigned* st) {
    XcdBarrier b; b.bar = bar; b.x = xb_xcc_id(); b.st = st;
    if (threadIdx.x == 0) (void)xb_add(&bar[XB_XCNT(b.x)], 1u);
    return b;
}
__device__ __forceinline__ void xcd_barrier_complete(unsigned* bar, unsigned x, unsigned& nloc, unsigned& nx) {
    const unsigned G = gridDim.x * gridDim.y * gridDim.z;
    unsigned sum, cnt, mine, sp = 0u;
    for (;;) {
        sum = 0u; cnt = 0u; mine = 0u;
#pragma unroll
        for (unsigned j = 0; j < 16; ++j) { const unsigned c = xb_ld(&bar[XB_XCNT(j)]); sum += c; cnt += (c > 0u) ? 1u : 0u; mine = (j == x) ? c : mine; }
        if (sum == G) break;
        __builtin_amdgcn_s_sleep(1);
        if ((++sp & 255u) == 0u) { if (xb_ld(&bar[XB_TMO])) break; if (sp > XB_SPIN_CAP) { atomicAdd(&bar[XB_TMO], 1u); break; } }
    }
    nloc = mine > 0u ? mine : 1u; nx = cnt > 0u ? cnt : 1u;
}
__device__ __forceinline__ void xcd_barrier(const XcdBarrier& b) {
    asm volatile("s_waitcnt vmcnt(0)" ::: "memory");
    __syncthreads();
    if (threadIdx.x == 0) {
        unsigned* bar = b.bar;
        __builtin_amdgcn_s_waitcnt(0);
        unsigned nloc = b.st[0], nx = b.st[1];
        if (nloc == 0u) { xcd_barrier_complete(bar, b.x, nloc, nx); b.st[0] = nloc; b.st[1] = nx; }
        const unsigned old = xb_add(&bar[XB_XSUB(b.x)], 1u);
        const unsigned gen = old / nloc;
        if (old + 1u == (gen + 1u) * nloc) {
            __builtin_amdgcn_fence(__ATOMIC_RELEASE, "agent");
            asm volatile("s_waitcnt vmcnt(0)" ::: "memory");
            const unsigned og = xb_add(&bar[XB_TOP], 1u);
            const unsigned tg = og / nx;
            if (og + 1u == (tg + 1u) * nx) xb_add(&bar[XB_TOPGEN], 1u);
            else XB_SPIN(xb_ld(&bar[XB_TOPGEN]) == tg, bar);
            __builtin_amdgcn_fence(__ATOMIC_ACQUIRE, "agent");
            xb_add(&bar[XB_XGEN(b.x)], 1u);
            asm volatile("s_waitcnt vmcnt(0)" ::: "memory");
        } else {
            XB_SPIN(xb_ld(&bar[XB_XGEN(b.x)]) == gen, bar);
            __builtin_amdgcn_fence(__ATOMIC_ACQUIRE, "agent");
            asm volatile("s_waitcnt vmcnt(0)" ::: "memory");
        }
    }
    __syncthreads();
}

constexpr int RING_BYTES = 131072;
constexpr int TR_WAVE_BYTES = 64 * 65 * 4;
constexpr int XSCR_OFF = 133120;
constexpr int MISC_OFF = XSCR_OFF + 2048;
constexpr int LDS_BYTES = 147456;

__device__ __forceinline__ float wave_sum(float v) {
#pragma unroll
    for (int o = 1; o < 64; o <<= 1) v += __shfl_xor(v, o);
    return v;
}

__device__ __forceinline__ void tr_item(const float* __restrict__ W, int N, bf16* __restrict__ Wt, int ldk, int coff, int mode, LAS float* scr, int item, int lane) {
    const int nblk = N >> 6, kb = item / nblk, nb = item - kb * nblk, k0 = kb << 6, n0 = nb << 6;
    const int rr = lane >> 4, cc = (lane & 15) * 4;
#pragma unroll 4
    for (int i = 0; i < 16; ++i) { const int kk = 4 * i + rr; const f32x4 v = *(const f32x4*)(W + (size_t)(k0 + kk) * N + n0 + cc);
        LAS float* d = scr + kk * 65 + cc; d[0] = v[0]; d[1] = v[1]; d[2] = v[2]; d[3] = v[3]; }
    const int c = lane & 7;
#pragma unroll
    for (int j = 0; j < 8; ++j) { const int n = (lane >> 3) + 8 * j; const LAS float* s = scr + (8 * c) * 65 + n;
        u32x4 o; o.x = cvtpk(s[0], s[65]); o.y = cvtpk(s[130], s[195]); o.z = cvtpk(s[260], s[325]); o.w = cvtpk(s[390], s[455]);
        const int ng = n0 + n; int row = ng;
        if (mode == 1) row = (ng >> 7) * 256 + (ng & 127); else if (mode == 2) row = (ng >> 7) * 256 + 128 + (ng & 127);
        *(u32x4*)(Wt + (size_t)row * ldk + coff + k0 + 8 * c) = o; }
}
__device__ __forceinline__ void mod_item(const float* __restrict__ c, const float* __restrict__ w_ada, const float* __restrict__ b_ada, float* __restrict__ mod, LAS float* sc, LAS float* part, int item, int tid, int lane, int wave) {
    for (int i = tid; i < NB * DM; i += 512) sc[i] = siluf_(c[i]);
    __syncthreads();
    const int n0 = item * 48, ln = lane < 48 ? lane : 0;
    float a0 = 0.f, a1 = 0.f, a2 = 0.f, a3 = 0.f;
    const float* wp = w_ada + (size_t)(wave * 256) * NMOD + n0 + ln;
    const LAS float* sk = sc + wave * 256;
#pragma unroll 8
    for (int k = 0; k < 256; ++k) { const float wv = wp[(size_t)k * NMOD]; a0 += sk[k] * wv; a1 += sk[DM + k] * wv; a2 += sk[2 * DM + k] * wv; a3 += sk[3 * DM + k] * wv; }
    part[(wave * 4 + 0) * 64 + lane] = a0; part[(wave * 4 + 1) * 64 + lane] = a1; part[(wave * 4 + 2) * 64 + lane] = a2; part[(wave * 4 + 3) * 64 + lane] = a3;
    __syncthreads();
    if (tid < 256) { const int b = tid >> 6, l = tid & 63;
        if (l < 48) { float s = 0.f;
#pragma unroll
            for (int w = 0; w < 8; ++w) s += part[(w * 4 + b) * 64 + l];
            mod[b * NMOD + n0 + l] = s + b_ada[n0 + l]; } }
    __syncthreads();
}

__device__ __forceinline__ void norm_rows(const float* __restrict__ x, const float* __restrict__ g, const float* __restrict__ mod, int shift_off, int scale_off, bf16* __restrict__ out, int gw, int NGW, int lane) {
    for (int row = gw; row < M; row += NGW) {
        const f32x4* xr = (const f32x4*)(x + (size_t)row * DM) + lane;
        f32x4 v[8]; float ss = 0.f;
#pragma unroll
        for (int j = 0; j < 8; ++j) { v[j] = xr[64 * j]; ss += (v[j][0] * v[j][0] + v[j][1] * v[j][1]) + (v[j][2] * v[j][2] + v[j][3] * v[j][3]); }
        ss = wave_sum(ss);
        const float rstd = 1.0f / sqrtf(ss * (1.0f / DM) + EPS);
        const float* mb = mod + (row >> 11) * NMOD;
#pragma unroll
        for (int j = 0; j < 8; ++j) { const int c = 4 * lane + 256 * j;
            const f32x4 gv = *(const f32x4*)(g + c), sc = *(const f32x4*)(mb + scale_off + c), sh = *(const f32x4*)(mb + shift_off + c);
            const f32x4 y = v[j] * rstd * gv * (sc + 1.0f) + sh;
            u32x2 w; w.x = cvtpk(y[0], y[1]); w.y = cvtpk(y[2], y[3]);
            *(u32x2*)(out + (size_t)row * DM + c) = w; }
    }
}
__device__ __forceinline__ void final_rows(float* __restrict__ x, const float* __restrict__ g, int gw, int NGW, int lane) {
    for (int row = gw; row < M; row += NGW) {
        f32x4* xr = (f32x4*)(x + (size_t)row * DM) + lane;
        f32x4 v[8]; float ss = 0.f;
#pragma unroll
        for (int j = 0; j < 8; ++j) { v[j] = xr[64 * j]; ss += (v[j][0] * v[j][0] + v[j][1] * v[j][1]) + (v[j][2] * v[j][2] + v[j][3] * v[j][3]); }
        ss = wave_sum(ss);
        const float rstd = 1.0f / sqrtf(ss * (1.0f / DM) + EPS);
#pragma unroll
        for (int j = 0; j < 8; ++j) { const f32x4 gv = *(const f32x4*)(g + 4 * lane + 256 * j); xr[64 * j] = v[j] * rstd * gv; }
    }
}
__device__ __forceinline__ void merge_rows(bf16* __restrict__ qkv, const float* __restrict__ lse, int gw, int NGW, int lane) {
    const int jh = lane >> 4, dd = (lane & 15) * 8;
    for (int row = gw; row < M; row += NGW) {
        bf16* rp = qkv + (size_t)row * NQKV;
        const float l0 = lse[(size_t)(0 * M + row) * 4 + jh], l1 = lse[(size_t)(1 * M + row) * 4 + jh], l2 = lse[(size_t)(2 * M + row) * 4 + jh];
        const u32x4 o0 = *(const u32x4*)(rp + C_QDL + 0 * 512 + jh * HD + dd), o1 = *(const u32x4*)(rp + C_QDL + 1 * 512 + jh * HD + dd), o2 = *(const u32x4*)(rp + C_QDL + 2 * 512 + jh * HD + dd);
        const float mm = fmaxf(l0, fmaxf(l1, l2));
        float w0 = __builtin_amdgcn_exp2f(l0 - mm), w1 = __builtin_amdgcn_exp2f(l1 - mm), w2 = __builtin_amdgcn_exp2f(l2 - mm);
        const float inv = 1.0f / (w0 + w1 + w2); w0 *= inv; w1 *= inv; w2 *= inv;
        u32x4 r;
#pragma unroll
        for (int e = 0; e < 4; ++e) r[e] = cvtpk(w0 * blo(o0[e]) + w1 * blo(o1[e]) + w2 * blo(o2[e]), w0 * bhi(o0[e]) + w1 * bhi(o1[e]) + w2 * bhi(o2[e]));
        *(u32x4*)(rp + C_ODL + jh * HD + dd) = r;
    }
}

__device__ __forceinline__ int crow(int r, int hi) { return (r & 3) + 8 * (r >> 2) + 4 * hi; }
typedef short v4i16_t __attribute__((ext_vector_type(4)));
__device__ __forceinline__ s16x4 vtr(const LAS unsigned char* p) { return __builtin_bit_cast(s16x4, __builtin_amdgcn_ds_read_tr16_b64_v4i16((LAS v4i16_t*)p)); }
#define ATT_WAIT_V(n) asm volatile("s_waitcnt vmcnt(" #n ")" ::: "memory")
#define ATT_WAIT_L() asm volatile("s_waitcnt lgkmcnt(0)" ::: "memory")
template <bool SB>
__device__ __forceinline__ void attn_unit(bf16* __restrict__ qkv, LAS unsigned char* wl, LAS float* wscr, int lane, int rowbase, int dil, int qcol, int kcol, int vcol, int qt, float slope2, float* __restrict__ lse_out) {
    const int q = lane & 31, hi = lane >> 5, lrow = lane >> 4, lch = lane & 15;
    const unsigned rstride = (unsigned)(dil * NQKV) * 2u;
    unsigned ko[4];
#pragma unroll
    for (int i = 0; i < 4; ++i) ko[i] = (unsigned)lrow * rstride + (unsigned)((lch ^ (4 * i + lrow)) << 4);
    const unsigned vo = (unsigned)((lane >> 2) & 7) * rstride + (unsigned)((4 * (lane >> 5) + (lane & 3)) << 4);
    const char* kbase = (const char*)(qkv + kcol); const char* vbase = (const char*)(qkv + vcol);
#define DMA_K(jt_) do { const unsigned tb_ = (unsigned)(rowbase + (jt_) * 32 * dil) * (unsigned)(NQKV * 2); \
        _Pragma("unroll") for (int p_ = 0; p_ < 8; ++p_) __builtin_amdgcn_global_load_lds((const unsigned*)(kbase + (size_t)(tb_ + (unsigned)(4 * p_) * rstride + ko[p_ & 3])), (LAS unsigned*)(wl + p_ * 1024), 16, 0, 0); } while (0)
#define DMA_V(jt_) do { const unsigned tb_ = (unsigned)(rowbase + (jt_) * 32 * dil) * (unsigned)(NQKV * 2); \
        _Pragma("unroll") for (int p_ = 0; p_ < 8; ++p_) __builtin_amdgcn_global_load_lds((const unsigned*)(vbase + (size_t)(tb_ + (unsigned)((p_ >> 1) * 8) * rstride + (unsigned)((p_ & 1) * 128) + vo)), (LAS unsigned*)(wl + 8192 + p_ * 1024), 16, 0, 0); } while (0)
    ATT_WAIT_L();
    DMA_K(qt); DMA_V(qt);
    bf16x8 qf[8];
    { const bf16* qp = qkv + (size_t)(rowbase + (qt * 32 + q) * dil) * NQKV + qcol + 8 * hi;
#pragma unroll
      for (int s = 0; s < 8; ++s) qf[s] = *(const bf16x8*)(qp + 16 * s); }
    f32x16 o[4];
#pragma unroll
    for (int d = 0; d < 4; ++d)
#pragma unroll
        for (int r = 0; r < 16; ++r) o[d][r] = 0.f;
    const LAS unsigned char* vb = wl + 8192 + (4 * hi + ((lane & 15) >> 2)) * 64 + ((lane >> 4) & 1) * 32 + (lane & 3) * 8;
    const LAS unsigned char* kb = wl + q * 256;
    const int kx = q & 15;
    int jt = qt; const int jt_end = SB ? 0 : (qt > 4 ? qt - 4 : 0);
    float carry = 0.f, mrun = -1e30f, lrun = 0.f;
    bool first = true;
    for (;;) {
        const bool more = jt > jt_end;
        if (first) ATT_WAIT_V(0); else ATT_WAIT_V(8);
        f32x16 s;
#pragma unroll
        for (int r = 0; r < 16; ++r) s[r] = 0.f;
#pragma unroll
        for (int st = 0; st < 8; ++st) { const bf16x8 kf = *(const LAS bf16x8*)(kb + (((2 * st + hi) ^ kx) << 4)); s = __builtin_amdgcn_mfma_f32_32x32x16_bf16(kf, qf[st], s, 0, 0, 0); }
        ATT_WAIT_L();
        if (more) DMA_K(jt - 1);
        float p[16];
        if (SB) {
            const bool diag = (jt == qt);
            float c[16], G[4];
#pragma unroll
            for (int g = 0; g < 4; ++g) { float run = 0.f;
#pragma unroll
                for (int i = 3; i >= 0; --i) { const int r = 4 * g + i; const float z = s[r];
                    const float spv = fmaxf(z, 0.f) + __builtin_amdgcn_logf(1.0f + __builtin_amdgcn_exp2f(-fabsf(z)));
                    const bool valid = !diag || (crow(r, hi) < q);
                    run += valid ? spv : 0.f; c[r] = run; }
                G[g] = run; }
            float Go[4], T[4];
#pragma unroll
            for (int g = 0; g < 4; ++g) { Go[g] = __shfl_xor(G[g], 32); T[g] = G[g] + Go[g]; }
            const float S2 = T[3], S1 = T[3] + T[2], S0 = S1 + T[1];
            const float off[4] = {carry + S0 + (hi == 0 ? Go[0] : 0.f), carry + S1 + (hi == 0 ? Go[1] : 0.f), carry + S2 + (hi == 0 ? Go[2] : 0.f), carry + (hi == 0 ? Go[3] : 0.f)};
#pragma unroll
            for (int r = 0; r < 16; ++r) { const bool valid = !diag || (crow(r, hi) < q); p[r] = valid ? __builtin_amdgcn_exp2f(s[r] - (off[r >> 2] + c[r])) : 0.f; }
            carry += S0 + T[0];
        } else {
            const int dt = qt - jt;
            float mx = -1e30f;
#pragma unroll
            for (int r = 0; r < 16; ++r) { const int rel = 32 * dt + q - crow(r, hi); const bool valid = (rel >= 0) && (rel <= 128);
                const float sv = valid ? s[r] - slope2 * (float)rel : -1e30f; p[r] = sv; mx = fmaxf(mx, sv); }
            mx = fmaxf(mx, __shfl_xor(mx, 32));
            const float mnew = fmaxf(mrun, mx), f = __builtin_amdgcn_exp2f(mrun - mnew);
            float rs = 0.f;
#pragma unroll
            for (int r = 0; r < 16; ++r) { p[r] = __builtin_amdgcn_exp2f(p[r] - mnew); rs += p[r]; }
            rs += __shfl_xor(rs, 32);
            lrun = lrun * f + rs; mrun = mnew;
            if (!__all(f == 1.0f)) {
                wscr[q] = f;
#pragma unroll
                for (int g = 0; g < 4; ++g) { const f32x4 fv = *(const LAS f32x4*)(wscr + 8 * g + 4 * hi);
#pragma unroll
                    for (int d = 0; d < 4; ++d) { o[d][4 * g + 0] *= fv[0]; o[d][4 * g + 1] *= fv[1]; o[d][4 * g + 2] *= fv[2]; o[d][4 * g + 3] *= fv[3]; } }
            }
        }
        u32x4 pa, pb;
        pa.x = cvtpk(p[0], p[1]); pa.y = cvtpk(p[2], p[3]); pa.z = cvtpk(p[4], p[5]); pa.w = cvtpk(p[6], p[7]);
        pb.x = cvtpk(p[8], p[9]); pb.y = cvtpk(p[10], p[11]); pb.z = cvtpk(p[12], p[13]); pb.w = cvtpk(p[14], p[15]);
        const bf16x8 pf0 = __builtin_bit_cast(bf16x8, pa), pf1 = __builtin_bit_cast(bf16x8, pb);
        if (more) ATT_WAIT_V(8); else ATT_WAIT_V(0);
#pragma unroll
        for (int d = 0; d < 4; ++d) {
            const s16x4 a0 = vtr(vb + (0 * 4 + d) * 512), a1 = vtr(vb + (1 * 4 + d) * 512), b0 = vtr(vb + (2 * 4 + d) * 512), b1 = vtr(vb + (3 * 4 + d) * 512);
            const bf16x8 v0 = {a0[0], a0[1], a0[2], a0[3], a1[0], a1[1], a1[2], a1[3]}, v1 = {b0[0], b0[1], b0[2], b0[3], b1[0], b1[1], b1[2], b1[3]};
            o[d] = __builtin_amdgcn_mfma_f32_32x32x16_bf16(pf0, v0, o[d], 0, 0, 0);
            o[d] = __builtin_amdgcn_mfma_f32_32x32x16_bf16(pf1, v1, o[d], 0, 0, 0);
        }
        if (!more) break;
        if (SB) { if (__all(carry > 150.0f)) break; }
        ATT_WAIT_L();
        DMA_V(jt - 1);
        --jt; first = false;
    }
#undef DMA_K
#undef DMA_V
    ATT_WAIT_V(0); ATT_WAIT_L();
    float fac[16];
    if (SB) {
#pragma unroll
        for (int r = 0; r < 16; ++r) fac[r] = 1.0f;
    } else {
        wscr[q] = 1.0f / lrun;
        if (hi == 0) lse_out[(size_t)(rowbase + (qt * 32 + q) * dil) * 4] = mrun + __builtin_amdgcn_logf(lrun);
#pragma unroll
        for (int g = 0; g < 4; ++g) { const f32x4 fv = *(const LAS f32x4*)(wscr + 8 * g + 4 * hi); fac[4 * g] = fv[0]; fac[4 * g + 1] = fv[1]; fac[4 * g + 2] = fv[2]; fac[4 * g + 3] = fv[3]; }
    }
    LAS float* stg = (LAS float*)wl;
#pragma unroll
    for (int d = 0; d < 4; ++d)
#pragma unroll
        for (int r = 0; r < 16; ++r) stg[crow(r, hi) * 128 + 32 * d + q] = o[d][r] * fac[r];
    unsigned ooff = (unsigned)((rowbase + (qt * 32 + lrow) * dil) * NQKV + qcol + lch * 8) * 2u; asm volatile("" : "+v"(ooff) :: "memory");
    char* obase = (char*)qkv;
#pragma unroll
    for (int p_ = 0; p_ < 8; ++p_) { const int row = 4 * p_ + lrow; const LAS f32x4* src = (const LAS f32x4*)(stg + row * 128 + lch * 8);
        const f32x4 a = src[0], b = src[1];
        u32x4 w; w.x = cvtpk(a[0], a[1]); w.y = cvtpk(a[2], a[3]); w.z = cvtpk(b[0], b[1]); w.w = cvtpk(b[2], b[3]);
        *(u32x4*)(obase + (size_t)(ooff + (unsigned)(4 * p_) * rstride)) = w; }
}

struct Args { const float* in[15]; float* out; unsigned char* ws; int ph_lo, ph_hi, flags, li; };
constexpr int NPHASE = 11;
__global__ void __launch_bounds__(512, 2) mk_fwd(Args a) {
    extern __shared__ __attribute__((aligned(16))) unsigned char lds_raw[];
    LAS unsigned char* lds = (LAS unsigned char*)lds_raw;
    const int tid = threadIdx.x, lane = tid & 63, wave = __builtin_amdgcn_readfirstlane(tid >> 6);
    const int G = gridDim.x, bx = blockIdx.x, vcu = (G % 8 == 0) ? (bx % 8) * (G / 8) + bx / 8 : bx;
    const int gw = vcu * 8 + wave, NGW = G * 8;
    unsigned char* ws = a.ws;
    float* mod = (float*)(ws + WS_MOD); float* lse = (float*)(ws + WS_LSE);
    bf16 *win = (bf16*)(ws + WS_WIN), *wproj = (bf16*)(ws + WS_WPROJ), *wout = (bf16*)(ws + WS_WOUT), *wgu = (bf16*)(ws + WS_WGU), *wdn = (bf16*)(ws + WS_WDN);
    bf16 *xn = (bf16*)(ws + WS_XN), *qkv = (bf16*)(ws + WS_QKV), *gates = (bf16*)(ws + WS_GATES);
    const float* x = a.in[0]; float* out = a.out;
    volatile LAS unsigned* misc = (volatile LAS unsigned*)(lds + MISC_OFF);
    if (tid < 4) misc[tid] = 0u;
    __syncthreads();
    const int lo = a.ph_lo, hi = a.ph_hi;
    unsigned* barw = (unsigned*)(ws + WS_CTL) + a.li * XCD_BAR_WORDS;
    XcdBarrier bar; bar.bar = barw; bar.x = 0; bar.st = misc;
    if (hi - lo > 1) bar = xcd_barrier_post(barw, misc);
#define IN(k) (lo <= (k) && (k) < hi)
#define SEAM(k) do { if (IN(k) && IN((k) + 1)) xcd_barrier(bar); } while (0)

    if (IN(0)) {
        if (bx < 256) mod_item(a.in[1], a.in[2], a.in[3], mod, (LAS float*)lds, (LAS float*)(lds + 32768), bx, tid, lane, wave);
        LAS float* scr = (LAS float*)(lds + wave * TR_WAVE_BYTES);
        constexpr int I_IN = (DM / 64) * (INC / 64), I_SB = (SBW / 64) * (DM / 64), I_DL = (DLO / 64) * (DM / 64), I_OUT = (DM / 64) * (DM / 64), I_FG = (DM / 64) * (DFF / 64), I_FD = (DFF / 64) * (DM / 64);
        constexpr int NITEMS = I_IN + I_SB + I_DL + I_OUT + 2 * I_FG + I_FD;
        for (int it = gw; it < NITEMS; it += NGW) {
            int r = it;
            if (r < I_IN) { tr_item(a.in[7], INC, win, DM, 0, 0, scr, r, lane); continue; } r -= I_IN;
            if (r < I_SB) { tr_item(a.in[9], DM, wproj, KPROJ, 0, 0, scr, r, lane); continue; } r -= I_SB;
            if (r < I_DL) { tr_item(a.in[10], DM, wproj, KPROJ, SBW, 0, scr, r, lane); continue; } r -= I_DL;
            if (r < I_OUT) { tr_item(a.in[11], DM, wout, DM, 0, 0, scr, r, lane); continue; } r -= I_OUT;
            if (r < I_FG) { tr_item(a.in[12], DFF, wgu, DM, 0, 1, scr, r, lane); continue; } r -= I_FG;
            if (r < I_FG) { tr_item(a.in[13], DFF, wgu, DM, 0, 2, scr, r, lane); continue; } r -= I_FG;
            tr_item(a.in[14], DM, wdn, DFF, 0, 0, scr, r, lane);
        }
    }
    SEAM(0);
    if (IN(1)) norm_rows(x, a.in[4], mod, 0, DM, xn, gw, NGW, lane);
    SEAM(1);
    if (IN(2)) {
        pg8::Gemm g{xn, win, DM, DM, DM}; pg8::StaticOrder S; S.init(M, INC, G, bx);
        EpiInProj E{qkv, gates, a.in[8]};
        pg8::gemm_phase<EpiInProj, pg8::StaticOrder, true, true>(lds, g, S, E);
    }
    SEAM(2);
    if (IN(3)) {
        LAS unsigned char* wl = lds + wave * 16384; LAS float* wscr = (LAS float*)(lds + XSCR_OFF + wave * 256);
        int lane3 = threadIdx.x & 63; asm volatile("" : "+v"(lane3));
        if (a.flags & 1)
            for (int u = gw; u < 2048; u += NGW) { const int b = u >> 9, h = (u >> 6) & 7, qt = u & 63;
                attn_unit<true>(qkv, wl, wscr, lane3, b * SEQ, 1, C_QSB + h * HD, C_KSB + h * HD, C_VSB + h * HD, qt, 0.f, nullptr); }
        if (a.flags & 2)
            for (int v = gw; v < 3072; v += NGW) {
                const int g = v >> 10, rem = v & 1023, b = rem >> 8, jh = (rem >> 6) & 3, xx = rem & 63;
                const int dil = g == 0 ? 1 : (g == 1 ? 4 : 16), r = g == 0 ? 0 : (g == 1 ? (xx >> 4) : (xx >> 2)), qt = g == 0 ? xx : (g == 1 ? (xx & 15) : (xx & 3));
                const float slope2 = exp2f(-8.0f * (float)(g * 4 + jh + 1) / 12.0f) * (float)dil * LOG2E;
                const int co = g * 512 + jh * HD;
                attn_unit<false>(qkv, wl, wscr, lane3, b * SEQ + r, dil, C_QDL + co, C_KDL + co, C_VDL + co, qt, slope2, lse + (size_t)g * M * 4 + jh);
            }
    }
    SEAM(3);
    if (IN(4)) merge_rows(qkv, lse, gw, NGW, lane);
    SEAM(4);
    if (IN(5)) {
        pg8::Gemm g{qkv, wproj, NQKV, KPROJ, KPROJ}; pg8::StaticOrder S; S.init(M, DM, G, bx);
        EpiProjGate E{gates, xn};
        pg8::gemm_phase<EpiProjGate, pg8::StaticOrder, true, true>(lds, g, S, E);
    }
    SEAM(5);
    if (IN(6)) {
        pg8::Gemm g{xn, wout, DM, DM, DM}; pg8::StaticOrder S; S.init(M, DM, G, bx);
        EpiRes E{x, out, mod + 2 * DM};
        pg8::gemm_phase<EpiRes, pg8::StaticOrder, true, true>(lds, g, S, E);
    }
    SEAM(6);
    if (IN(7)) norm_rows(out, a.in[5], mod, 3 * DM, 4 * DM, xn, gw, NGW, lane);
    SEAM(7);
    if (IN(8)) {
        pg8::Gemm g{xn, wgu, DM, DM, DM}; pg8::StaticOrder S; S.init(M, 2 * DFF, G, bx);
        EpiSwiglu E{qkv};
        pg8::gemm_phase<EpiSwiglu, pg8::StaticOrder, true, true>(lds, g, S, E);
    }
    SEAM(8);
    if (IN(9)) {
        pg8::Gemm g{qkv, wdn, DFF, DFF, DFF}; pg8::StaticOrder S; S.init(M, DM, G, bx);
        EpiRes E{out, out, mod + 5 * DM};
        pg8::gemm_phase<EpiRes, pg8::StaticOrder, true, true>(lds, g, S, E);
    }
    SEAM(9);
    if (IN(10)) final_rows(out, a.in[6], gw, NGW, lane);
#undef IN
#undef SEAM
}

#if defined(MK_MASK) && (MK_MASK != 0x7FF || (defined(ATT_FLAGS) && ATT_FLAGS != 3))
__global__ void k_transpose(const float* __restrict__ W, bf16* __restrict__ Wt, int K, int N, int ldk, int coff, int mode, int pad_) {
    __shared__ float t[32][33];
    const int n0 = blockIdx.x * 32, k0 = blockIdx.y * 32, tx = threadIdx.x & 31, ty = threadIdx.x >> 5;
    for (int i = ty; i < 32; i += 8) t[i][tx] = W[(size_t)(k0 + i) * N + n0 + tx];
    __syncthreads();
    for (int i = ty; i < 32; i += 8) {
        const int n = n0 + i; int row = n;
        if (mode == 1) row = (n >> 7) * 256 + (n & 127); else if (mode == 2) row = (n >> 7) * 256 + 128 + (n & 127);
        Wt[(size_t)row * ldk + coff + k0 + tx] = (bf16)f2bf(t[tx][i]);
    }
}

__global__ void k_mod(const float* __restrict__ c, const float* __restrict__ w, const float* __restrict__ bias, float* __restrict__ mod) {
    __shared__ float sc[NB][DM];
    for (int i = threadIdx.x; i < NB * DM; i += blockDim.x) sc[i / DM][i % DM] = siluf_(c[i]);
    __syncthreads();
    const int n = blockIdx.x * blockDim.x + threadIdx.x;
    float a0 = 0, a1 = 0, a2 = 0, a3 = 0;
    for (int k = 0; k < DM; ++k) { const float wv = w[(size_t)k * NMOD + n]; a0 += sc[0][k] * wv; a1 += sc[1][k] * wv; a2 += sc[2][k] * wv; a3 += sc[3][k] * wv; }
    const float bv = bias[n];
    mod[0 * NMOD + n] = a0 + bv; mod[1 * NMOD + n] = a1 + bv; mod[2 * NMOD + n] = a2 + bv; mod[3 * NMOD + n] = a3 + bv;
}

__device__ __forceinline__ float block_sum(float v, float* red) {
    for (int o = 32; o > 0; o >>= 1) v += __shfl_xor(v, o);
    const int w = threadIdx.x >> 6, nw = blockDim.x >> 6;
    __syncthreads();
    if ((threadIdx.x & 63) == 0) red[w] = v;
    __syncthreads();
    float s = 0; for (int i = 0; i < nw; ++i) s += red[i];
    return s;
}
__device__ __forceinline__ float block_max(float v, float* red) {
    for (int o = 32; o > 0; o >>= 1) v = fmaxf(v, __shfl_xor(v, o));
    const int w = threadIdx.x >> 6, nw = blockDim.x >> 6;
    __syncthreads();
    if ((threadIdx.x & 63) == 0) red[w] = v;
    __syncthreads();
    float s = red[0]; for (int i = 1; i < nw; ++i) s = fmaxf(s, red[i]);
    return s;
}

__global__ void k_norm_mod(const float* __restrict__ x, const float* __restrict__ g, const float* __restrict__ mod, bf16* __restrict__ out, int shift_off, int scale_off) {
    __shared__ float red[8];
    const int row = blockIdx.x, b = row / SEQ;
    const float* xr = x + (size_t)row * DM;
    float v[8]; float ss = 0;
    for (int i = 0; i < 8; ++i) { v[i] = xr[threadIdx.x + 256 * i]; ss += v[i] * v[i]; }
    ss = block_sum(ss, red);
    const float rstd = 1.0f / sqrtf(ss * (1.0f / DM) + EPS);
    for (int i = 0; i < 8; ++i) { const int cidx = threadIdx.x + 256 * i;
        const float y = v[i] * rstd * g[cidx] * (1.0f + mod[b * NMOD + scale_off + cidx]) + mod[b * NMOD + shift_off + cidx];
        out[(size_t)row * DM + cidx] = (bf16)f2bf(y); }
}
__global__ void k_final(float* __restrict__ x, const float* __restrict__ g) {
    __shared__ float red[8];
    const int row = blockIdx.x; float* xr = x + (size_t)row * DM;
    float v[8]; float ss = 0;
    for (int i = 0; i < 8; ++i) { v[i] = xr[threadIdx.x + 256 * i]; ss += v[i] * v[i]; }
    ss = block_sum(ss, red);
    const float rstd = 1.0f / sqrtf(ss * (1.0f / DM) + EPS);
    for (int i = 0; i < 8; ++i) { const int cidx = threadIdx.x + 256 * i; xr[cidx] = v[i] * rstd * g[cidx]; }
}

struct Seg { int akoff, bkoff, klen, browoff; };
template <int NSEG, class Epi>
__global__ void __launch_bounds__(256) k_gemm(const bf16* __restrict__ A, const bf16* __restrict__ Bt, Epi E, Seg s0, Seg s1, int lda, int ldb, int bstride, int pad_) {
    __shared__ float As[16][132], Bs[16][132];
    const int tid = threadIdx.x, tx = tid & 15, ty = tid >> 4;
    const int m0 = blockIdx.y * 128, nb = blockIdx.x;
    float acc[NSEG][8][8];
    for (int s = 0; s < NSEG; ++s) for (int i = 0; i < 8; ++i) for (int j = 0; j < 8; ++j) acc[s][i][j] = 0.f;
    const int lr = tid >> 1, lk = (tid & 1) * 8;
#pragma unroll
    for (int s = 0; s < NSEG; ++s) {
        const Seg sg = s == 0 ? s0 : s1;
        const bf16* Ap = A + (size_t)(m0 + lr) * lda + sg.akoff + lk;
        const bf16* Bp = Bt + (size_t)(nb * bstride + sg.browoff + lr) * ldb + sg.bkoff + lk;
        for (int k0 = 0; k0 < sg.klen; k0 += 16) {
            const u32x4 av = *(const u32x4*)(Ap + k0), bv = *(const u32x4*)(Bp + k0);
            __syncthreads();
#pragma unroll
            for (int i = 0; i < 4; ++i) {
                As[lk + 2 * i][lr] = __builtin_bit_cast(float, av[i] << 16); As[lk + 2 * i + 1][lr] = __builtin_bit_cast(float, av[i] & 0xffff0000u);
                Bs[lk + 2 * i][lr] = __builtin_bit_cast(float, bv[i] << 16); Bs[lk + 2 * i + 1][lr] = __builtin_bit_cast(float, bv[i] & 0xffff0000u);
            }
            __syncthreads();
#pragma unroll
            for (int kk = 0; kk < 16; ++kk) {
                const f32x4 a0 = *(const f32x4*)&As[kk][ty * 8], a1 = *(const f32x4*)&As[kk][ty * 8 + 4];
                const f32x4 b0 = *(const f32x4*)&Bs[kk][tx * 8], b1 = *(const f32x4*)&Bs[kk][tx * 8 + 4];
                const float a[8] = {a0[0], a0[1], a0[2], a0[3], a1[0], a1[1], a1[2], a1[3]};
                const float b[8] = {b0[0], b0[1], b0[2], b0[3], b1[0], b1[1], b1[2], b1[3]};
#pragma unroll
                for (int i = 0; i < 8; ++i)
#pragma unroll
                    for (int j = 0; j < 8; ++j) acc[s][i][j] += a[i] * b[j];
            }
        }
    }
#pragma unroll
    for (int i = 0; i < 8; ++i) E(m0 + ty * 8 + i, nb, tx * 8, acc[0][i], acc[NSEG - 1][i]);
}

struct NEpiInProj { bf16* qkv; bf16* gates; const float* bgate;
    __device__ void operator()(int row, int nb, int c0, const float (&a)[8], const float (&)[8]) const {
        const int col = nb * 128 + c0;
        if (col < NQKV) { const float sc = (col < 1024 || (col >= 3072 && col < 4608)) ? QSCALE : 1.0f; for (int j = 0; j < 8; ++j) qkv[(size_t)row * NQKV + col + j] = (bf16)f2bf(a[j] * sc); }
        else { const int gc = col - NQKV; for (int j = 0; j < 8; ++j) gates[(size_t)row * 4096 + gc + j] = (bf16)f2bf(sigmoidf_(a[j] + bgate[gc + j])); }
    } };
struct NEpiProj { const bf16* gates; bf16* u;
    __device__ void operator()(int row, int nb, int c0, const float (&a)[8], const float (&b)[8]) const {
        const int col = nb * 128 + c0;
        for (int j = 0; j < 8; ++j) { const float gs = bf2f(gates[(size_t)row * 4096 + col + j]), gd = bf2f(gates[(size_t)row * 4096 + 2048 + col + j]);
            u[(size_t)row * DM + col + j] = (bf16)f2bf(gs * a[j] + gd * b[j]); }
    } };
struct NEpiRes { const float* base; float* out; const float* mod; int gate_off; int pad;
    __device__ void operator()(int row, int nb, int c0, const float (&a)[8], const float (&)[8]) const {
        const int col = nb * 128 + c0, b = row / SEQ;
        for (int j = 0; j < 8; ++j) out[(size_t)row * DM + col + j] = base[(size_t)row * DM + col + j] + mod[b * NMOD + gate_off + col + j] * a[j];
    } };
struct NEpiSwiglu { bf16* a2;
    __device__ void operator()(int row, int nb, int c0, const float (&g)[8], const float (&u)[8]) const {
        const int col = nb * 128 + c0;
        for (int j = 0; j < 8; ++j) a2[(size_t)row * DFF + col + j] = (bf16)f2bf(siluf_(g[j]) * u[j]);
    } };

__global__ void __launch_bounds__(256) k_attn_sb(bf16* __restrict__ qkv) {
    __shared__ float zs[SEQ], sps[SEQ], qf[HD], red[2][HD];
    const int t = blockIdx.x % SEQ, h = (blockIdx.x / SEQ) % SBH, b = blockIdx.x / (SEQ * SBH), tid = threadIdx.x;
    const size_t rowq = (size_t)(b * SEQ + t) * NQKV;
    if (tid < HD) qf[tid] = bf2f(qkv[rowq + C_QSB + h * HD + tid]);
    __syncthreads();
    const float scale = 0.6931471805599453f;
    for (int s = tid; s < t; s += 256) {
        const bf16* kr = qkv + (size_t)(b * SEQ + s) * NQKV + C_KSB + h * HD;
        float z = 0;
        for (int d0 = 0; d0 < HD; d0 += 8) { const u32x4 kv = *(const u32x4*)(kr + d0);
            for (int i = 0; i < 4; ++i) { z += qf[d0 + 2 * i] * __builtin_bit_cast(float, kv[i] << 16) + qf[d0 + 2 * i + 1] * __builtin_bit_cast(float, kv[i] & 0xffff0000u); } }
        z *= scale; zs[s] = z; sps[s] = fmaxf(z, 0.f) + log1pf(__expf(-fabsf(z)));
    }
    __syncthreads();
    if (tid == 0) { float run = 0.f; for (int s = t - 1; s >= 0; --s) { run += sps[s]; zs[s] = __expf(zs[s] - run); } }
    __syncthreads();
    const int d = tid & 127, half = tid >> 7; float o = 0.f;
    for (int s = half; s < t; s += 2) o += zs[s] * bf2f(qkv[(size_t)(b * SEQ + s) * NQKV + C_VSB + h * HD + d]);
    red[half][d] = o;
    __syncthreads();
    if (tid < HD) qkv[rowq + C_QSB + h * HD + tid] = (bf16)f2bf(red[0][tid] + red[1][tid]);
}

__global__ void __launch_bounds__(256) k_attn_dil(bf16* __restrict__ qkv) {
    __shared__ float qf[HD], ps[256], red8[8], red[2][HD];
    const int jh = blockIdx.x & 3, t = (blockIdx.x >> 2) % SEQ, b = blockIdx.x / (4 * SEQ), tid = threadIdx.x;
    const size_t rowq = (size_t)(b * SEQ + t) * NQKV;
    const float scale = 0.6931471805599453f;
    float og[3] = {0.f, 0.f, 0.f}, lse[3];
#pragma unroll
    for (int g = 0; g < 3; ++g) {
        const int dil = g == 0 ? 1 : (g == 1 ? 4 : 16);
        const int i = t / dil, nk = (i < 128 ? i : 128) + 1;
        const float slope = exp2f(-8.0f * (float)(g * 4 + jh + 1) / 12.0f);
        __syncthreads();
        if (tid < HD) qf[tid] = bf2f(qkv[rowq + C_QDL + g * 512 + jh * HD + tid]);
        __syncthreads();
        float sc = -INFINITY;
        if (tid < nk) {
            const bf16* kr = qkv + (size_t)(b * SEQ + t - tid * dil) * NQKV + C_KDL + g * 512 + jh * HD;
            float z = 0;
            for (int d0 = 0; d0 < HD; d0 += 8) { const u32x4 kv = *(const u32x4*)(kr + d0);
                for (int k = 0; k < 4; ++k) { z += qf[d0 + 2 * k] * __builtin_bit_cast(float, kv[k] << 16) + qf[d0 + 2 * k + 1] * __builtin_bit_cast(float, kv[k] & 0xffff0000u); } }
            sc = z * scale - slope * (float)(dil * tid);
        }
        const float mx = block_max(sc, red8);
        const float p = tid < nk ? __expf(sc - mx) : 0.f;
        const float l = block_sum(p, red8);
        ps[tid] = p / l;
        __syncthreads();
        lse[g] = mx + logf(l);
        const int d = tid & 127, half = tid >> 7; float o = 0.f;
        for (int r = half; r < nk; r += 2) o += ps[r] * bf2f(qkv[(size_t)(b * SEQ + t - r * dil) * NQKV + C_VDL + g * 512 + jh * HD + d]);
        red[half][d] = o;
        __syncthreads();
        if (tid < HD) og[g] = red[0][tid] + red[1][tid];
    }
    const float mm = fmaxf(lse[0], fmaxf(lse[1], lse[2]));
    const float w0 = __expf(lse[0] - mm), w1 = __expf(lse[1] - mm), w2 = __expf(lse[2] - mm), ws = w0 + w1 + w2;
    if (tid < HD) qkv[rowq + C_ODL + jh * HD + tid] = (bf16)f2bf((w0 * og[0] + w1 * og[1] + w2 * og[2]) / ws);
}

#endif

#ifndef MK_MASK
#define MK_MASK 0x7FF
#endif
#ifndef ATT_FLAGS
#define ATT_FLAGS 3
#endif
extern "C" void kernel_launch(void* const* d_in, const int* in_sizes, int n_in, void* d_out, int out_size, void* d_ws, size_t ws_size, hipStream_t stream) {
    static int inited = 0;
    if (!inited) {
        if (n_in != 15 || out_size != M * DM || ws_size < WS_END) { fprintf(stderr, "kernel_launch: unexpected sizes (n_in %d out %d ws %zu)\n", n_in, out_size, ws_size); inited = -1; return; }
        if (hipFuncSetAttribute((const void*)mk_fwd, hipFuncAttributeMaxDynamicSharedMemorySize, LDS_BYTES) != hipSuccess) { fprintf(stderr, "kernel_launch: hipFuncSetAttribute failed\n"); inited = -1; return; }
        int per_cu = 0, cus = 0, dev = 0; (void)hipGetDevice(&dev); (void)hipDeviceGetAttribute(&cus, hipDeviceAttributeMultiprocessorCount, dev);
        (void)hipOccupancyMaxActiveBlocksPerMultiprocessor(&per_cu, (const void*)mk_fwd, 512, LDS_BYTES);
        if (per_cu < 1 || cus < 256) fprintf(stderr, "kernel_launch: note: occupancy query says %d workgroups per CU on %d CUs; the grid is 256 workgroups, one per CU\n", per_cu, cus);
        (void)hipGetLastError();
        inited = 1;
    }
    if (inited < 0) return;
    unsigned char* ws = (unsigned char*)d_ws; float* out = (float*)d_out;
    (void)hipMemsetAsync(ws + WS_CTL, 0, CTL_ZERO_BYTES, stream);
    Args a{};
    for (int i = 0; i < 15; ++i) a.in[i] = (const float*)d_in[i];
    a.out = out; a.ws = ws;
    int li = 0;
    auto mk = [&](int lo, int hi, int flags) { a.ph_lo = lo; a.ph_hi = hi; a.flags = flags; a.li = li++; hipLaunchKernelGGL(mk_fwd, dim3(256), dim3(512), LDS_BYTES, stream, a); };
#if MK_MASK == 0x7FF && ATT_FLAGS == 3
    mk(0, NPHASE, 3);
#else
    const float* x = a.in[0];
    float* mod = (float*)(ws + WS_MOD);
    bf16 *win = (bf16*)(ws + WS_WIN), *wproj = (bf16*)(ws + WS_WPROJ), *wout = (bf16*)(ws + WS_WOUT), *wgu = (bf16*)(ws + WS_WGU), *wdn = (bf16*)(ws + WS_WDN);
    bf16 *xn = (bf16*)(ws + WS_XN), *qkv = (bf16*)(ws + WS_QKV), *gates = (bf16*)(ws + WS_GATES);
    int p = 0;
    while (p < NPHASE) {
        const bool ismk = (MK_MASK >> p) & 1;
        if (ismk && !(p == 3 && ATT_FLAGS != 3) && !(p == 4 && !((MK_MASK >> 3) & 1))) {
            int e = p + 1;
            while (e < NPHASE && ((MK_MASK >> e) & 1) && !(e == 3 && ATT_FLAGS != 3)) ++e;
            mk(p, e, 3); p = e; continue;
        }
        switch (p) {
        case 0:
            k_transpose<<<dim3(INC / 32, DM / 32), 256, 0, stream>>>(a.in[7], win, DM, INC, DM, 0, 0, 0);
            k_transpose<<<dim3(DM / 32, SBW / 32), 256, 0, stream>>>(a.in[9], wproj, SBW, DM, KPROJ, 0, 0, 0);
            k_transpose<<<dim3(DM / 32, DLO / 32), 256, 0, stream>>>(a.in[10], wproj, DLO, DM, KPROJ, SBW, 0, 0);
            k_transpose<<<dim3(DM / 32, DM / 32), 256, 0, stream>>>(a.in[11], wout, DM, DM, DM, 0, 0, 0);
            k_transpose<<<dim3(DFF / 32, DM / 32), 256, 0, stream>>>(a.in[12], wgu, DM, DFF, DM, 0, 1, 0);
            k_transpose<<<dim3(DFF / 32, DM / 32), 256, 0, stream>>>(a.in[13], wgu, DM, DFF, DM, 0, 2, 0);
            k_transpose<<<dim3(DM / 32, DFF / 32), 256, 0, stream>>>(a.in[14], wdn, DFF, DM, DFF, 0, 0, 0);
            k_mod<<<NMOD / 256, 256, 0, stream>>>(a.in[1], a.in[2], a.in[3], mod);
            break;
        case 1: k_norm_mod<<<M, 256, 0, stream>>>(x, a.in[4], mod, xn, 0, DM); break;
        case 2: { Seg s{0, 0, DM, 0}; k_gemm<1, NEpiInProj><<<dim3(INC / 128, M / 128), 256, 0, stream>>>(xn, win, NEpiInProj{qkv, gates, a.in[8]}, s, s, DM, DM, 128, 0); } break;
        case 3:
            if (ismk && ATT_FLAGS == 1) { mk(3, 4, 1); k_attn_dil<<<NB * SEQ * 4, 256, 0, stream>>>(qkv); }
            else if (ismk && ATT_FLAGS == 2) { k_attn_sb<<<NB * SBH * SEQ, 256, 0, stream>>>(qkv); mk(3, 5, 2); }
            else { k_attn_sb<<<NB * SBH * SEQ, 256, 0, stream>>>(qkv); k_attn_dil<<<NB * SEQ * 4, 256, 0, stream>>>(qkv); }
            ++p;
            break;
        case 4: break;
        case 5: { Seg s0{0, 0, SBW, 0}, s1{SBW, SBW, DLO, 0}; k_gemm<2, NEpiProj><<<dim3(DM / 128, M / 128), 256, 0, stream>>>(qkv, wproj, NEpiProj{gates, xn}, s0, s1, NQKV, KPROJ, 128, 0); } break;
        case 6: { Seg s{0, 0, DM, 0}; k_gemm<1, NEpiRes><<<dim3(DM / 128, M / 128), 256, 0, stream>>>(xn, wout, NEpiRes{x, out, mod, 2 * DM, 0}, s, s, DM, DM, 128, 0); } break;
        case 7: k_norm_mod<<<M, 256, 0, stream>>>(out, a.in[5], mod, xn, 3 * DM, 4 * DM); break;
        case 8: { Seg s0{0, 0, DM, 0}, s1{0, 0, DM, 128}; k_gemm<2, NEpiSwiglu><<<dim3(DFF / 128, M / 128), 256, 0, stream>>>(xn, wgu, NEpiSwiglu{qkv}, s0, s1, DM, DM, 256, 0); } break;
        case 9: { Seg s{0, 0, DFF, 0}; k_gemm<1, NEpiRes><<<dim3(DM / 128, M / 128), 256, 0, stream>>>(qkv, wdn, NEpiRes{out, out, mod, 5 * DM, 0}, s, s, DFF, DFF, 128, 0); } break;
        case 10: k_final<<<M, 256, 0, stream>>>(out, a.in[6]); break;
        }
        ++p;
    }
#endif
}
```
